# Optimizing an MI355X kernel written in HIP

```python
import jax, jax.numpy as jnp
from jax import lax
import numpy as np

D_MODEL = 1024
BATCH = 4
SEQ = 4096
DEPTH = 4

GRID_W = 64
RET_HEADS = 4
RET_DK = 128
RET_DV = 256
NA_HEADS = 16
NA_DH = 64
NA_WIN_ROWS = 8
NA_WIN_COLS = 16
ML_HEADS = 4
ML_DK = 128
ML_DV = 256
ML_CONV_W = 5
CHUNK = 128
D_FF = -(-8 * D_MODEL // (3 * 256)) * 256
ROPE_BASE = 10000.0
EPS = 1e-6
N_BRANCH = 3
RET_QK = RET_HEADS * RET_DK
RET_V = RET_HEADS * RET_DV
NA_W = NA_HEADS * NA_DH
ML_QK = ML_HEADS * ML_DK
ML_V = ML_HEADS * ML_DV
IN_SPLITS = (RET_QK, RET_QK, RET_V, RET_V, NA_W, NA_W, NA_W, ML_QK, ML_QK, ML_V, ML_V, 4 * ML_HEADS, N_BRANCH * D_MODEL)
IN_W = sum(IN_SPLITS)

kernel_name = "hybrid_retention_natten_mlstm_encoder"


def rmsnorm(x, g):
    xf = x.astype(jnp.float32)
    y = xf * lax.rsqrt(jnp.mean(xf * xf, axis=-1, keepdims=True) + EPS)
    return (y * g.astype(jnp.float32)).astype(x.dtype)


def head_layernorm(x):
    xf = x.astype(jnp.float32)
    mu = jnp.mean(xf, axis=-1, keepdims=True)
    xc = xf - mu
    return xc * lax.rsqrt(jnp.mean(xc * xc, axis=-1, keepdims=True) + EPS)


def split_heads(t, heads):
    B, T, _ = t.shape
    return t.reshape(B, T, heads, -1).transpose(0, 2, 1, 3)


def merge_heads(t):
    B, H, T, d = t.shape
    return t.transpose(0, 2, 1, 3).reshape(B, T, H * d)


def rotary(x, cos, sin):
    x1, x2 = jnp.split(x, 2, axis=-1)
    return jnp.concatenate([x1 * cos - x2 * sin, x1 * sin + x2 * cos], axis=-1)


def retention_dir(q, k, v, log_gamma, include_diag):
    B, H, T, dk = q.shape
    dv = v.shape[-1]
    nc = T // CHUNK
    qc = q.reshape(B, H, nc, CHUNK, dk)
    kc = k.reshape(B, H, nc, CHUNK, dk)
    vc = v.reshape(B, H, nc, CHUNK, dv)
    pos = jnp.arange(CHUNK, dtype=jnp.float32)
    diff = pos[:, None] - pos[None, :]
    mask = (diff >= 0) if include_diag else (diff > 0)
    decay = jnp.where(mask, jnp.exp(log_gamma[:, None, None] * jnp.maximum(diff, 0.0)), 0.0)
    s = jnp.einsum('bhcid,bhcjd->bhcij', qc, kc) * decay[:, None]
    o_intra = jnp.einsum('bhcij,bhcje->bhcie', s, vc)
    k_w = kc * jnp.exp(log_gamma[:, None] * (CHUNK - 1 - pos))[:, None, :, None]
    s_chunk = jnp.einsum('bhcjd,bhcje->bhcde', k_w, vc)
    chunk_decay = jnp.exp(log_gamma * CHUNK)[None, :, None, None]

    def step(R, S):
        return chunk_decay * R + S, R

    _, r_prev = lax.scan(step, jnp.zeros((B, H, dk, dv), s_chunk.dtype), jnp.moveaxis(s_chunk, 2, 0))
    r_prev = jnp.moveaxis(r_prev, 0, 2)
    q_w = qc * jnp.exp(log_gamma[:, None] * (pos + 1.0))[:, None, :, None]
    o_inter = jnp.einsum('bhcid,bhcde->bhcie', q_w, r_prev)
    return (o_intra + o_inter).reshape(B, H, T, dv)


def retention_branch(rq, rk, rv, rg, decay_logit, cos, sin):
    B, T, _ = rq.shape
    q = rotary(split_heads(rq, RET_HEADS), cos, sin) * (RET_DK ** -0.5)
    k = rotary(split_heads(rk, RET_HEADS), cos, sin)
    v = split_heads(rv, RET_HEADS)
    lg_f = jax.nn.log_sigmoid(decay_logit[0].astype(jnp.float32))
    lg_b = jax.nn.log_sigmoid(decay_logit[1].astype(jnp.float32))
    fwd = retention_dir(q, k, v, lg_f, True)
    bwd = jnp.flip(retention_dir(jnp.flip(q, 2), jnp.flip(k, 2), jnp.flip(v, 2), lg_b, False), 2)
    y = merge_heads(head_layernorm(fwd + bwd)).astype(rg.dtype)
    return jax.nn.silu(rg) * y


def neighbourhood_attention(q, k, v, rpb):
    B, T, _ = q.shape
    rows = T // GRID_W
    wr = min(NA_WIN_ROWS, rows)
    wc = NA_WIN_COLS

    def grid(t):
        return t.reshape(B, rows, GRID_W, NA_HEADS, NA_DH).transpose(0, 3, 1, 2, 4)

    qg = jnp.moveaxis(grid(q), 2, 0)
    kg, vg = grid(k), grid(v)
    col = jnp.arange(GRID_W)
    col_idx = jnp.clip(col - wc // 2, 0, GRID_W - wc)[:, None] + jnp.arange(wc)[None, :]
    col_rel = col_idx - col[:, None] + (NA_WIN_COLS - 1)
    rpb_cols = rpb[:, :, col_rel]
    scale = NA_DH ** -0.5

    def row_block(args):
        r, q_r = args
        rs = jnp.clip(r - wr // 2, 0, rows - wr)
        k_r = lax.dynamic_slice_in_dim(kg, rs, wr, axis=2)[:, :, :, col_idx]
        v_r = lax.dynamic_slice_in_dim(vg, rs, wr, axis=2)[:, :, :, col_idx]
        row_rel = rs + jnp.arange(wr) - r + (NA_WIN_ROWS - 1)
        bias = rpb_cols[:, row_rel].transpose(0, 2, 1, 3)
        s = jnp.einsum('bhqd,bhrqjd->bhqrj', q_r, k_r).astype(jnp.float32) * scale + bias.astype(jnp.float32)
        p = jax.nn.softmax(s.reshape(B, NA_HEADS, GRID_W, wr * wc), axis=-1)
        p = p.reshape(B, NA_HEADS, GRID_W, wr, wc).astype(v_r.dtype)
        return jnp.einsum('bhqrj,bhrqjd->bhqd', p, v_r)

    out = lax.map(row_block, (jnp.arange(rows), qg))
    return out.transpose(1, 0, 3, 2, 4).reshape(B, T, NA_W)


def centred_depthwise_conv(x, w, b):
    K, C = w.shape
    out = lax.conv_general_dilated(x, w[:, None, :], window_strides=(1,), padding=[(K // 2, K // 2)],
                                   dimension_numbers=('NWC', 'WIO', 'NWC'), feature_group_count=C)
    return out + b


def mlstm_dir(q, k, v, i_pre, log_f):
    B, H, T, dk = q.shape
    dv = v.shape[-1]
    nc = T // CHUNK
    qc = q.reshape(B, H, nc, CHUNK, dk)
    kc = k.reshape(B, H, nc, CHUNK, dk)
    vc = v.reshape(B, H, nc, CHUNK, dv)
    ic = i_pre.reshape(B, H, nc, CHUNK)
    b = jnp.cumsum(log_f.reshape(B, H, nc, CHUNK), axis=-1)
    pos = jnp.arange(CHUNK)
    causal = pos[:, None] >= pos[None, :]
    d_log = jnp.where(causal, b[..., :, None] - b[..., None, :] + ic[..., None, :], -jnp.inf)
    b_last = b[..., -1]
    a = b_last[..., None] - b + ic
    m_loc = jnp.max(a, axis=-1)
    w = jnp.exp(a - m_loc[..., None])
    c_loc = jnp.einsum('bhcj,bhcjd,bhcje->bhcde', w, kc, vc)
    n_loc = jnp.einsum('bhcj,bhcjd->bhcd', w, kc)

    def step(carry, xs):
        C, n, m = carry
        bl, ml, cl, nl = xs
        m_new = jnp.maximum(bl + m, ml)
        s_old = jnp.exp(bl + m - m_new)
        s_new = jnp.exp(ml - m_new)
        C_new = s_old[..., None, None] * C + s_new[..., None, None] * cl
        n_new = s_old[..., None] * n + s_new[..., None] * nl
        return (C_new, n_new, m_new), (C, n, m)

    init = (jnp.zeros((B, H, dk, dv), c_loc.dtype), jnp.zeros((B, H, dk), n_loc.dtype),
            jnp.full((B, H), -jnp.inf, jnp.float32))
    xs = (jnp.moveaxis(b_last, 2, 0), jnp.moveaxis(m_loc, 2, 0), jnp.moveaxis(c_loc, 2, 0), jnp.moveaxis(n_loc, 2, 0))
    _, (c_prev, n_prev, m_prev) = lax.scan(step, init, xs)
    c_prev = jnp.moveaxis(c_prev, 0, 2)
    n_prev = jnp.moveaxis(n_prev, 0, 2)
    m_prev = jnp.moveaxis(m_prev, 0, 2)
    g = b + m_prev[..., None]
    m_t = jnp.maximum(g, jnp.max(d_log, axis=-1))
    s_inter = jnp.exp(g - m_t)
    s = jnp.einsum('bhcid,bhcjd->bhcij', qc, kc) * jnp.exp(d_log - m_t[..., None])
    num = s_inter[..., None] * jnp.einsum('bhcid,bhcde->bhcie', qc, c_prev) + jnp.einsum('bhcij,bhcje->bhcie', s, vc)
    den = s_inter * jnp.einsum('bhcid,bhcd->bhci', qc, n_prev) + jnp.sum(s, axis=-1)
    h = num / jnp.maximum(jnp.abs(den), jnp.exp(-m_t))[..., None]
    return h.reshape(B, H, T, dv)


def mlstm_branch(mq, mk, mv, mo, mgate, conv_w, conv_b, gate_b, norm_g):
    B, T, _ = mq.shape
    qk = jax.nn.silu(centred_depthwise_conv(jnp.concatenate([mq, mk], axis=-1), conv_w, conv_b))
    q_in, k_in = jnp.split(qk, 2, axis=-1)
    q = split_heads(q_in, ML_HEADS) * (ML_DK ** -0.5)
    k = split_heads(k_in, ML_HEADS)
    v = split_heads(mv, ML_HEADS)
    pre = mgate.astype(jnp.float32).reshape(B, T, 2, 2, ML_HEADS) + gate_b.astype(jnp.float32)
    pre = pre.transpose(2, 3, 0, 4, 1)
    fwd = mlstm_dir(q, k, v, pre[0, 0], jax.nn.log_sigmoid(pre[0, 1]))
    bwd = mlstm_dir(jnp.flip(q, 2), jnp.flip(k, 2), jnp.flip(v, 2),
                    jnp.flip(pre[1, 0], -1), jnp.flip(jax.nn.log_sigmoid(pre[1, 1]), -1))
    h = merge_heads(head_layernorm(fwd + jnp.flip(bwd, 2))) * norm_g.astype(jnp.float32)
    return jax.nn.sigmoid(mo) * h.astype(mo.dtype)


def setup_inputs(seed: int = 0) -> dict:
    key = jax.random.key(seed)
    ks = jax.random.split(key, 24)
    f32 = jnp.float32

    def nrm(k, shape, scale):
        return jax.random.normal(k, shape, f32) * scale

    x = nrm(ks[0], (BATCH, SEQ, D_MODEL), 1.0)
    norm1_g = 1.0 + nrm(ks[1], (DEPTH, D_MODEL), 0.02)
    w_in = nrm(ks[2], (DEPTH, D_MODEL, IN_W), D_MODEL ** -0.5)
    gate_b = nrm(ks[3], (DEPTH, N_BRANCH * D_MODEL), 0.02)
    ret_base = jnp.log(2.0 ** (5.0 + jnp.arange(RET_HEADS, dtype=f32)) - 1.0)
    ret_decay_logit = ret_base[None, None, :] + nrm(ks[4], (DEPTH, 2, RET_HEADS), 0.1)
    na_rpb = nrm(ks[5], (DEPTH, NA_HEADS, 2 * NA_WIN_ROWS - 1, 2 * NA_WIN_COLS - 1), 0.02)
    ml_conv_w = nrm(ks[6], (DEPTH, ML_CONV_W, 2 * ML_QK), ML_CONV_W ** -0.5)
    ml_conv_b = nrm(ks[7], (DEPTH, 2 * ML_QK), 0.02)
    i_bias = nrm(ks[8], (DEPTH, 2, 1, ML_HEADS), 0.1)
    f_bias = jnp.linspace(3.0, 6.0, ML_HEADS, dtype=f32)[None, None, None, :] + nrm(ks[9], (DEPTH, 2, 1, ML_HEADS), 0.1)
    ml_gate_b = jnp.concatenate([i_bias, f_bias], axis=2)
    ml_norm_g = 1.0 + nrm(ks[10], (DEPTH, ML_V), 0.02)
    w_ret_o = nrm(ks[11], (DEPTH, RET_V, D_MODEL), RET_V ** -0.5)
    w_na_o = nrm(ks[12], (DEPTH, NA_W, D_MODEL), NA_W ** -0.5)
    w_ml_o = nrm(ks[13], (DEPTH, ML_V, D_MODEL), ML_V ** -0.5)
    w_out = nrm(ks[14], (DEPTH, D_MODEL, D_MODEL), D_MODEL ** -0.5)
    norm2_g = 1.0 + nrm(ks[15], (DEPTH, D_MODEL), 0.02)
    w_ffn_up = nrm(ks[16], (DEPTH, D_MODEL, 2 * D_FF), D_MODEL ** -0.5)
    w_ffn_down = nrm(ks[17], (DEPTH, D_FF, D_MODEL), D_FF ** -0.5)
    final_g = 1.0 + nrm(ks[18], (D_MODEL,), 0.02)
    return {"x": x, "norm1_g": norm1_g, "w_in": w_in, "gate_b": gate_b, "ret_decay_logit": ret_decay_logit,
            "na_rpb": na_rpb, "ml_conv_w": ml_conv_w, "ml_conv_b": ml_conv_b, "ml_gate_b": ml_gate_b,
            "ml_norm_g": ml_norm_g, "w_ret_o": w_ret_o, "w_na_o": w_na_o, "w_ml_o": w_ml_o, "w_out": w_out,
            "norm2_g": norm2_g, "w_ffn_up": w_ffn_up, "w_ffn_down": w_ffn_down, "final_g": final_g}


def reference(x, norm1_g, w_in, gate_b, ret_decay_logit, na_rpb, ml_conv_w, ml_conv_b, ml_gate_b, ml_norm_g,
              w_ret_o, w_na_o, w_ml_o, w_out, norm2_g, w_ffn_up, w_ffn_down, final_g):
    B, T, _ = x.shape
    half = RET_DK // 2
    inv_freq = ROPE_BASE ** (-jnp.arange(half, dtype=jnp.float32) / half)
    ang = jnp.arange(T, dtype=jnp.float32)[:, None] * inv_freq[None, :]
    cos, sin = jnp.cos(ang), jnp.sin(ang)
    split_at = np.cumsum(IN_SPLITS)[:-1]
    for l in range(DEPTH):
        h = rmsnorm(x, norm1_g[l])
        proj = h @ w_in[l]
        (rq, rk, rv, rg, nq, nk, nv, mq, mk, mv, mo, mgate, mix_gate) = jnp.split(proj, split_at, axis=-1)
        y_ret = retention_branch(rq, rk, rv, rg, ret_decay_logit[l], cos, sin)
        y_na = neighbourhood_attention(nq, nk, nv, na_rpb[l])
        y_ml = mlstm_branch(mq, mk, mv, mo, mgate, ml_conv_w[l], ml_conv_b[l], ml_gate_b[l], ml_norm_g[l])
        gates = jax.nn.sigmoid((mix_gate + gate_b[l]).astype(jnp.float32)).astype(x.dtype)
        g_ret, g_na, g_ml = jnp.split(gates, N_BRANCH, axis=-1)
        merged = g_ret * (y_ret @ w_ret_o[l]) + g_na * (y_na @ w_na_o[l]) + g_ml * (y_ml @ w_ml_o[l])
        x = x + merged @ w_out[l]
        h2 = rmsnorm(x, norm2_g[l])
        a, u = jnp.split(h2 @ w_ffn_up[l], 2, axis=-1)
        x = x + (jax.nn.silu(a) * u) @ w_ffn_down[l]
    return rmsnorm(x, final_g)
```

```cpp
#include <hip/hip_runtime.h>
#include <hip/hip_cooperative_groups.h>
#include <cstdio>
#include <cstdint>
namespace cg = cooperative_groups;
namespace pg8 {
#define PG8_LAS __attribute__((address_space(3)))
typedef unsigned short bf16_t;
typedef short bf16x8 __attribute__((ext_vector_type(8)));
typedef float f32x4 __attribute__((ext_vector_type(4)));
typedef unsigned u32x4 __attribute__((ext_vector_type(4)));
constexpr int BM = 256, BK = 64, HALF = 128, HTB = HALF * BK * 2  , STAGE_BYTES = 8 * HTB, NXCD = 8, WGM = 8;

__host__ __device__ __forceinline__ int lds_byte(int r, int c) { const int st = (r >> 4) * 2 + (c >> 5), rr = r & 15, cc = c & 31, ob = rr * 64 + cc * 2; return st * 1024 + (ob ^ (((ob >> 9) & 1) << 5)); }
__host__ __device__ __forceinline__ void stage_rc(int b, int& R, int& C) { const int st = b / 1024, sb = b % 1024, swz = sb ^ (((sb >> 9) & 1) << 5); R = (st >> 1) * 16 + swz / 64; C = (st & 1) * 32 + (swz % 64) / 2; }
__host__ __device__ __forceinline__ int perm32(int rho) { const int n = rho >> 4, i = rho & 15; return 8 * (i >> 2) + 4 * n + (i & 3); }

struct Unit { int pm, pn; };
struct Gemm { const bf16_t* A; const bf16_t* Bt; int M, N, K, lda, ldb; };

struct StaticOrder {
    int nM, nN, nwg, G, c, wgm = 4;
    __host__ __device__ void init(int M, int N, int G_, int c_) { nM = M / BM; nN = N / BM; nwg = nM * nN; G = G_; c = c_; }
    __host__ __device__ bool next(int i, Unit& u) const {
        const long L = (long)i * G + c; if (L >= nwg) return false;
        int wgid = (int)L; { const int q = nwg / NXCD, r = nwg % NXCD, xcd = wgid % NXCD, off = wgid / NXCD; wgid = (xcd < r ? xcd * (q + 1) : r * (q + 1) + (xcd - r) * q) + off; }
        const int nig = wgm * nN, gid = wgid / nig, fm = gid * wgm, gsz = (nM - fm) < wgm ? (nM - fm) : wgm;
        u.pm = fm + ((wgid % nig) % gsz); u.pn = (wgid % nig) / gsz; return true;
    }
    __device__ __forceinline__ size_t a_off(const Unit&) const { return 0; }
    __device__ __forceinline__ void a_ready(const Unit&) const {}
    __device__ __forceinline__ void done(const Unit&) const {}
};

template <class Epi, class Sched, bool ALIGN_EPI = false, bool SP2 = false>
__device__ __forceinline__ void gemm_phase(PG8_LAS unsigned char* lds, const Gemm g, const Sched& S, const Epi& E) {
    int tid0_ = threadIdx.x; asm volatile("" : "+v"(tid0_));
    const int tid = tid0_, wid = __builtin_amdgcn_readfirstlane(tid >> 6), lane = tid & 63, wr = wid >> 2, wc = wid & 3, fr = lane & 15, fq = lane >> 4;
    const int K = g.K, nt = K / BK;
    unsigned voffA[2], voffB[2];
#pragma unroll
    for (int i = 0; i < 2; ++i) { int R, C; stage_rc(tid * 16 + i * 8192, R, C); const int Rb = Epi::PERM ? ((R & ~31) + perm32(R & 31)) : R;
        voffA[i] = (unsigned)(R * g.lda + C) * 2u; voffB[i] = (unsigned)(Rb * g.ldb + C) * 2u; }
    const size_t kstep = (size_t)(BK * 2);
    const size_t hstepA = (size_t)HALF * g.lda * 2, hstepB = (size_t)HALF * g.ldb * 2;
    const size_t tstepA = 2 * hstepA, tstepB = 2 * hstepB;
    const unsigned ldsw = (unsigned)wid * 1024u;
    const int aoff = lds_byte(wr * 64 + fr, fq * 8), boff = lds_byte(wc * 32 + fr, fq * 8);
#define PG8_SA(b, h) (((b) * 2 + (h)) * HTB)
#define PG8_SB(b, h) ((4 + (b) * 2 + (h)) * HTB)
#define PG8_STAGE(bufoff, gbase, voff) do { _Pragma("unroll") for (int _i = 0; _i < 2; ++_i) \
        __builtin_amdgcn_global_load_lds((const unsigned*)((const char*)(gbase) + (voff)[_i]), (PG8_LAS unsigned*)(lds + (bufoff) + ldsw + _i * 8192), 16, 0, 0); } while (0)
#define PG8_LDA(dst, b, h) do { _Pragma("unroll") for (int m = 0; m < 4; ++m) _Pragma("unroll") for (int k = 0; k < 2; ++k) dst[m][k] = *(const PG8_LAS bf16x8*)(lds + PG8_SA(b, h) + aoff + m * 2048 + k * 1024); } while (0)
#define PG8_LDB(dst, b, h) do { _Pragma("unroll") for (int n = 0; n < 2; ++n) _Pragma("unroll") for (int k = 0; k < 2; ++k) dst[n][k] = *(const PG8_LAS bf16x8*)(lds + PG8_SB(b, h) + boff + n * 2048 + k * 1024); } while (0)
#define PG8_MMA(ai, bj, At, Bt) do { __builtin_amdgcn_s_setprio(1); _Pragma("unroll") for (int m = 0; m < 4; ++m) _Pragma("unroll") for (int n = 0; n < 2; ++n) _Pragma("unroll") for (int k = 0; k < 2; ++k) \
        acc[ai][bj][m][n] = __builtin_amdgcn_mfma_f32_16x16x32_bf16(Bt[n][k], At[m][k], acc[ai][bj][m][n], 0, 0, 0); __builtin_amdgcn_s_setprio(0); } while (0)
#define PG8_WAIT_V(n) asm volatile("s_waitcnt vmcnt(" #n ")" ::: "memory")
#define PG8_WAIT_L(n) asm volatile("s_waitcnt lgkmcnt(" #n ")" ::: "memory")
#define PG8_BAR __builtin_amdgcn_s_barrier()
#define PG8_SCHED __builtin_amdgcn_sched_barrier(0)
    Unit cur, nxt; int ui = 0;
    if (!S.next(0, cur)) return;
    f32x4 acc[2][2][4][2];
#pragma unroll
    for (int a = 0; a < 2; ++a)
#pragma unroll
        for (int b = 0; b < 2; ++b)
#pragma unroll
            for (int m = 0; m < 4; ++m)
#pragma unroll
                for (int n = 0; n < 2; ++n) acc[a][b][m][n] = (f32x4){0.f, 0.f, 0.f, 0.f};
    bf16x8 At[4][2], B0[2][2], B1[2][2];
    const char* cA = (const char*)g.A + (size_t)cur.pm * tstepA + S.a_off(cur); const char* cB = (const char*)g.Bt + (size_t)cur.pn * tstepB;
    S.a_ready(cur);
    if constexpr (SP2) {
        PG8_STAGE(PG8_SB(0, 0), cB, voffB); PG8_STAGE(PG8_SB(0, 1), cB + hstepB, voffB); PG8_STAGE(PG8_SA(0, 0), cA, voffA); PG8_STAGE(PG8_SA(0, 1), cA + hstepA, voffA);
        if (wr == 1) PG8_BAR;
        PG8_WAIT_V(2); PG8_BAR;
        PG8_STAGE(PG8_SB(1, 0), cB + kstep, voffB); PG8_STAGE(PG8_SA(1, 0), cA + kstep, voffA); PG8_STAGE(PG8_SB(1, 1), cB + hstepB + kstep, voffB);
        PG8_WAIT_V(6); PG8_BAR;
    } else {
        PG8_STAGE(PG8_SB(0, 0), cB, voffB); PG8_STAGE(PG8_SA(0, 0), cA, voffA); PG8_STAGE(PG8_SB(0, 1), cB + hstepB, voffB); PG8_STAGE(PG8_SA(0, 1), cA + hstepA, voffA);
        if (wr == 1) PG8_BAR;
        PG8_WAIT_V(4); PG8_BAR;
        PG8_STAGE(PG8_SB(1, 0), cB + kstep, voffB); PG8_STAGE(PG8_SA(1, 0), cA + kstep, voffA); PG8_STAGE(PG8_SB(1, 1), cB + hstepB + kstep, voffB);
        PG8_WAIT_V(6); PG8_BAR;
    }
    for (;;) {
        const bool has_next = __builtin_amdgcn_readfirstlane((int)S.next(ui + 1, nxt)) != 0;
        const char* nA = has_next ? (const char*)g.A + (size_t)nxt.pm * tstepA + S.a_off(nxt) : cA; const char* nB = has_next ? (const char*)g.Bt + (size_t)nxt.pn * tstepB : cB;
        for (int t = 0; t < nt; t += 2) {
            const bool last = (t == nt - 2);
            const char* a1 = cA + (size_t)(t + 1) * kstep;
            const char* a2 = last ? nA : cA + (size_t)(t + 2) * kstep; const char* b2 = last ? nB : cB + (size_t)(t + 2) * kstep;
            const char* a3 = a2 + kstep; const char* b3 = b2 + kstep;
            if (last && has_next) S.a_ready(nxt);
            if constexpr (SP2) {
            PG8_LDB(B0, 0, 0); PG8_LDB(B1, 0, 1); PG8_SCHED; PG8_LDA(At, 0, 0); PG8_STAGE(PG8_SA(1, 1), a1 + hstepA, voffA);
            PG8_WAIT_V(8); PG8_WAIT_L(0); PG8_BAR; PG8_MMA(0, 0, At, B0); PG8_MMA(0, 1, At, B1); PG8_BAR; PG8_SCHED;
            PG8_LDA(At, 0, 1); PG8_STAGE(PG8_SB(0, 0), b2, voffB); PG8_STAGE(PG8_SB(0, 1), b2 + hstepB, voffB); PG8_STAGE(PG8_SA(0, 0), a2, voffA);
            PG8_WAIT_V(8); PG8_WAIT_L(0); PG8_BAR; PG8_MMA(1, 0, At, B0); PG8_MMA(1, 1, At, B1); PG8_BAR; PG8_SCHED;
            PG8_LDB(B0, 1, 0); PG8_LDB(B1, 1, 1); PG8_SCHED; PG8_LDA(At, 1, 0); PG8_STAGE(PG8_SA(0, 1), a2 + hstepA, voffA);
            PG8_WAIT_V(8); PG8_WAIT_L(0); PG8_BAR; PG8_MMA(0, 0, At, B0); PG8_MMA(0, 1, At, B1); PG8_BAR; PG8_SCHED;
            PG8_LDA(At, 1, 1); PG8_STAGE(PG8_SB(1, 0), b3, voffB); PG8_STAGE(PG8_SB(1, 1), b3 + hstepB, voffB); PG8_STAGE(PG8_SA(1, 0), a3, voffA);
            PG8_WAIT_V(8); PG8_WAIT_L(0); PG8_BAR; PG8_MMA(1, 0, At, B0); PG8_MMA(1, 1, At, B1); PG8_BAR; PG8_SCHED;
            } else {
            PG8_LDB(B0, 0, 0); PG8_SCHED; PG8_LDA(At, 0, 0); PG8_STAGE(PG8_SA(1, 1), a1 + hstepA, voffA);
            PG8_WAIT_L(8); PG8_BAR; PG8_WAIT_L(0); PG8_MMA(0, 0, At, B0); PG8_BAR; PG8_SCHED;
            PG8_LDB(B1, 0, 1); PG8_STAGE(PG8_SB(0, 0), b2, voffB);
            PG8_BAR; PG8_WAIT_L(0); PG8_MMA(0, 1, At, B1); PG8_BAR;
            PG8_LDA(At, 0, 1); PG8_STAGE(PG8_SA(0, 0), a2, voffA);
            PG8_BAR; PG8_WAIT_L(0); PG8_MMA(1, 0, At, B0); PG8_BAR; PG8_SCHED;
            PG8_STAGE(PG8_SB(0, 1), b2 + hstepB, voffB);
            PG8_WAIT_V(6); PG8_BAR; PG8_MMA(1, 1, At, B1); PG8_BAR;
            PG8_LDB(B0, 1, 0); PG8_SCHED; PG8_LDA(At, 1, 0); PG8_STAGE(PG8_SA(0, 1), a2 + hstepA, voffA);
            PG8_WAIT_L(8); PG8_BAR; PG8_WAIT_L(0); PG8_MMA(0, 0, At, B0); PG8_BAR; PG8_SCHED;
            PG8_LDB(B1, 1, 1); PG8_STAGE(PG8_SB(1, 0), b3, voffB);
            PG8_BAR; PG8_WAIT_L(0); PG8_MMA(0, 1, At, B1); PG8_BAR;
            PG8_LDA(At, 1, 1); PG8_STAGE(PG8_SA(1, 0), a3, voffA);
            PG8_BAR; PG8_WAIT_L(0); PG8_MMA(1, 0, At, B0); PG8_BAR; PG8_SCHED;
            PG8_STAGE(PG8_SB(1, 1), b3 + hstepB, voffB);
            PG8_WAIT_V(6); PG8_BAR; PG8_MMA(1, 1, At, B1); PG8_BAR;
            }
        }
        if constexpr (ALIGN_EPI) { if (wr == 0) PG8_BAR; }
        if constexpr (!Epi::AFTER_DRAIN) { E(acc, cur, wr, wc, fr, fq); S.done(cur); }
        if (!has_next) break;
#pragma unroll
        for (int a = 0; a < 2; ++a)
#pragma unroll
            for (int b = 0; b < 2; ++b)
#pragma unroll
                for (int m = 0; m < 4; ++m)
#pragma unroll
                    for (int n = 0; n < 2; ++n) acc[a][b][m][n] = (f32x4){0.f, 0.f, 0.f, 0.f};
        cur = nxt; cA = nA; cB = nB; ++ui;
        if constexpr (ALIGN_EPI) { if (wr == 1) PG8_BAR; }
    }
    PG8_WAIT_V(0);
    if constexpr (!ALIGN_EPI) { if (wr == 0) PG8_BAR; }
    PG8_BAR;
    if constexpr (Epi::AFTER_DRAIN) { E.fused(acc, cur, wr, wc, fr, fq, lds, wid, lane); S.done(cur); }
#undef PG8_SA
#undef PG8_SB
#undef PG8_STAGE
#undef PG8_LDA
#undef PG8_LDB
#undef PG8_MMA
#undef PG8_WAIT_V
#undef PG8_WAIT_L
#undef PG8_BAR
#undef PG8_SCHED
}
}

#define DI __device__ __forceinline__
typedef unsigned short bf16_t;
typedef short bf16x8 __attribute__((ext_vector_type(8)));
typedef float f32x4 __attribute__((ext_vector_type(4)));
typedef unsigned u32x4 __attribute__((ext_vector_type(4)));
typedef unsigned u32x2 __attribute__((ext_vector_type(2)));

constexpr int NB = 4, SEQ = 4096, DM = 1024, MT = NB * SEQ, NL = 4;
constexpr int INW = 12304, NPJ = 9472, PJ = 9216, NVT = 3072, FF = 2816, FF2 = 5632;
constexpr float EPSF = 1e-6f;
constexpr int NTHR = 512;
constexpr int LDS_BYTES = 163840;

constexpr size_t SZ_WIN = (size_t)NPJ * DM * 2, SZ_WV = (size_t)NVT * DM * 2, SZ_WO = (size_t)DM * DM * 2, SZ_WUP = (size_t)FF2 * DM * 2, SZ_WDN = (size_t)DM * FF * 2;
constexpr size_t LW_WIN = 0, LW_WV = LW_WIN + SZ_WIN, LW_WO = LW_WV + SZ_WV, LW_WOUT = LW_WO + 3 * SZ_WO, LW_WUP = LW_WOUT + SZ_WO, LW_WDN = LW_WUP + SZ_WUP, LAYER_W = LW_WDN + SZ_WDN;
constexpr size_t OFF_WB = 0;
constexpr size_t OFF_PROJ = OFF_WB + NL * LAYER_W;
constexpr size_t OFF_VT = OFF_PROJ + (size_t)MT * PJ * 2;
constexpr size_t OFF_X = OFF_VT + (size_t)NVT * MT * 2;
constexpr size_t OFF_XB = OFF_X + (size_t)MT * DM * 4;
constexpr size_t OFF_ST = OFF_XB + (size_t)MT * DM * 2;
constexpr size_t OFF_COS = OFF_ST + (size_t)2 * 16 * 32 * 256 * 128 * 2;
constexpr size_t OFF_SIN = OFF_COS + (size_t)SEQ * 64 * 4;
constexpr size_t OFF_MG = OFF_SIN + (size_t)SEQ * 64 * 4;
constexpr size_t OFF_NS = OFF_MG + (size_t)MT * 16 * 4;
constexpr size_t OFF_CDEC = OFF_NS + (size_t)2 * 16 * 32 * 128 * 4;
constexpr size_t OFF_SS = OFF_CDEC + 8192;
constexpr size_t OFF_BAR = OFF_SS + (size_t)9 * MT * 16 * 4;
constexpr size_t BAR_BYTES = 16384;
constexpr size_t WS_END = OFF_BAR + BAR_BYTES;
constexpr size_t OFF_MF = OFF_VT, OFF_MB = OFF_VT + (size_t)MT * DM * 4;
static_assert(OFF_MB + (size_t)MT * DM * 2 <= OFF_X, "merged overlay");
constexpr size_t OFF_HID = OFF_PROJ;

struct Args { const float* in[18]; float* out; unsigned char* ws; };

typedef float f32x2_t __attribute__((ext_vector_type(2))); typedef __bf16 bf16x2_t __attribute__((ext_vector_type(2)));
DI unsigned pk2(float lo, float hi) { f32x2_t v = {lo, hi}; bf16x2_t b = __builtin_convertvector(v, bf16x2_t); return __builtin_bit_cast(unsigned, b); }
DI float bflo(unsigned w) { return __uint_as_float(w << 16); }
DI float bfhi(unsigned w) { return __uint_as_float(w & 0xffff0000u); }
DI float bf2f(bf16_t h) { return __uint_as_float((unsigned)h << 16); }
DI bf16_t f2bf(float f) { return (bf16_t)(pk2(f, 0.f) & 0xffffu); }
DI float sigm(float x) { return 1.f / (1.f + __expf(-x)); }
DI float silu(float x) { return x * sigm(x); }
DI float logsig(float x) { return fminf(x, 0.f) - log1pf(__expf(-fabsf(x))); }
DI float row_rstd(const float* ssp, int row) { const f32x4* p = (const f32x4*)(ssp + (size_t)row * 16); const f32x4 a = p[0], b = p[1], c = p[2], d = p[3];
    const float s = (((a[0] + a[1]) + (a[2] + a[3])) + ((b[0] + b[1]) + (b[2] + b[3]))) + (((c[0] + c[1]) + (c[2] + c[3])) + ((d[0] + d[1]) + (d[2] + d[3]))); return rsqrtf(s * (1.f / DM) + EPSF); }
DI int swz(int row, int col) { return row * 256 + ((((col >> 3) ^ (row & 15)) << 4) | ((col & 7) << 1)); }
DI int swzt(int row, int col) { return row * 256 + (((((col >> 3) ^ (row & 15) ^ ((row >> 4) & 7)) & 15) << 4) | ((col & 7) << 1)); }
DI f32x4 mfma16(bf16x8 a, bf16x8 b, f32x4 c) { return __builtin_amdgcn_mfma_f32_16x16x32_bf16(a, b, c, 0, 0, 0); }
DI void unpack8(u32x4 r, float (&o)[8]) { o[0] = bflo(r.x); o[1] = bfhi(r.x); o[2] = bflo(r.y); o[3] = bfhi(r.y); o[4] = bflo(r.z); o[5] = bfhi(r.z); o[6] = bflo(r.w); o[7] = bfhi(r.w); }
DI u32x4 pack8(const float (&v)[8]) { u32x4 w; w.x = pk2(v[0], v[1]); w.y = pk2(v[2], v[3]); w.z = pk2(v[4], v[5]); w.w = pk2(v[6], v[7]); return w; }

DI int find_slot(const int* pt, int nu, int tile) { int s = 0; for (int i = nu - 1; i >= 0; --i) if (pt[i] == tile) s = i; return s; }
struct EpiInProj {
    static constexpr bool PERM = true, AFTER_DRAIN = false;
    bf16_t* proj; const float* rt; const int* pt; int nu; const float* cosT; const float* sinT; const float* gate_b;
    template <int MODE>
    DI void body(const f32x4 (&acc)[2][2][4][2], const pg8::Unit& u, const float* rtu, int wr, int wc, int fr, int fq) const {
        const int pn = u.pn;
        f32x4 cs[2][4], sn[2][4], gb[2][2];
        if (MODE == 0) {
#pragma unroll
            for (int ai = 0; ai < 2; ++ai)
#pragma unroll
                for (int m = 0; m < 4; ++m) {
                    const int t = (u.pm * 256 + ai * 128 + wr * 64 + m * 16 + fr) & (SEQ - 1), i0 = wc * 16 + 4 * fq;
                    cs[ai][m] = *(const f32x4*)(cosT + t * 64 + i0); sn[ai][m] = *(const f32x4*)(sinT + t * 64 + i0);
                }
        }
        if (MODE == 5) {
#pragma unroll
            for (int bj = 0; bj < 2; ++bj) { const int c0 = pn * 256 + bj * 128 + wc * 32 + 8 * fq; gb[bj][0] = *(const f32x4*)(gate_b + c0 - 6144); gb[bj][1] = *(const f32x4*)(gate_b + c0 - 6144 + 4); }
        }
#pragma unroll
        for (int ai = 0; ai < 2; ++ai)
#pragma unroll
            for (int m = 0; m < 4; ++m) {
                const int row = u.pm * 256 + ai * 128 + wr * 64 + m * 16 + fr;
                const float rs = rtu[ai * 128 + wr * 64 + m * 16 + fr];
#pragma unroll
                for (int bj = 0; bj < 2; ++bj) {
                    const int c0 = pn * 256 + bj * 128 + wc * 32 + 8 * fq;
                    float v[8];
#pragma unroll
                    for (int k = 0; k < 4; ++k) { v[k] = acc[ai][bj][m][0][k] * rs; v[4 + k] = acc[ai][bj][m][1][k] * rs; }
                    if (MODE == 0) {
                        const float sc = bj == 0 ? 0.08838834764831845f : 1.f;
#pragma unroll
                        for (int k = 0; k < 4; ++k) { const float x1 = v[2 * k], x2 = v[2 * k + 1]; v[2 * k] = (x1 * cs[ai][m][k] - x2 * sn[ai][m][k]) * sc; v[2 * k + 1] = (x1 * sn[ai][m][k] + x2 * cs[ai][m][k]) * sc; }
                    } else if (MODE == 1) {
#pragma unroll
                        for (int k = 0; k < 8; ++k) v[k] = silu(v[k]);
                    } else if (MODE == 2) {
#pragma unroll
                        for (int k = 0; k < 8; ++k) v[k] *= 0.125f;
                    } else if (MODE == 4) {
#pragma unroll
                        for (int k = 0; k < 8; ++k) v[k] = sigm(v[k]);
                    } else if (MODE == 5) {
#pragma unroll
                        for (int k = 0; k < 4; ++k) { v[k] = sigm(v[k] + gb[bj][0][k]); v[4 + k] = sigm(v[4 + k] + gb[bj][1][k]); }
                    }
                    *(u32x4*)(proj + (size_t)row * PJ + c0) = pack8(v);
                }
            }
    }
    DI void operator()(const f32x4 (&acc)[2][2][4][2], const pg8::Unit& u, int wr, int wc, int fr, int fq) const {
        asm volatile("" : "+v"(fr), "+v"(fq));
        const int pn = u.pn;
        const float* rtu = rt + find_slot(pt, nu, u.pm) * 256;
        if (pn < 4) body<0>(acc, u, rtu, wr, wc, fr, fq);
        else if (pn < 8) body<1>(acc, u, rtu, wr, wc, fr, fq);
        else if (pn < 12) body<2>(acc, u, rtu, wr, wc, fr, fq);
        else if (pn < 20) body<3>(acc, u, rtu, wr, wc, fr, fq);
        else if (pn < 24) body<4>(acc, u, rtu, wr, wc, fr, fq);
        else body<5>(acc, u, rtu, wr, wc, fr, fq);
    }
};
struct EpiVt {
    static constexpr bool PERM = true, AFTER_DRAIN = false;
    bf16_t* vt; const float* rt; const int* pt;
    DI void operator()(const f32x4 (&acc)[2][2][4][2], const pg8::Unit& u, int wr, int wc, int fr, int fq) const {
        asm volatile("" : "+v"(fr), "+v"(fq));
#pragma unroll
        for (int bj = 0; bj < 2; ++bj) {
            const int c0 = u.pn * 256 + bj * 128 + wc * 32 + 8 * fq;
            const int slot = find_slot(pt, 3, u.pn);
            const float* rp = rt + slot * 256 + bj * 128 + wc * 32 + 8 * fq;
            const f32x4 s0 = *(const f32x4*)rp, s1 = *(const f32x4*)(rp + 4);
            float rs[8];
#pragma unroll
            for (int k = 0; k < 4; ++k) { rs[k] = s0[k]; rs[4 + k] = s1[k]; }
#pragma unroll
            for (int ai = 0; ai < 2; ++ai)
#pragma unroll
                for (int m = 0; m < 4; ++m) {
                    const int row = u.pm * 256 + ai * 128 + wr * 64 + m * 16 + fr;
                    float v[8];
#pragma unroll
                    for (int k = 0; k < 4; ++k) { v[k] = acc[ai][bj][m][0][k] * rs[k]; v[4 + k] = acc[ai][bj][m][1][k] * rs[4 + k]; }
                    *(u32x4*)(vt + (size_t)row * MT + c0) = pack8(v);
                }
        }
    }
};
struct OutProjOrder {
    pg8::StaticOrder S0;
    DI bool next(int i, pg8::Unit& u) const { if (i >= 3) return false; pg8::Unit b; if (!S0.next(0, b)) return false; u.pm = b.pm; u.pn = i * 4 + b.pn; return true; }
    DI size_t a_off(const pg8::Unit& u) const { const int br = u.pn >> 2; return (size_t)(br == 0 ? 1024 : (br == 1 ? 2048 : 5120)) * 2; }
    DI void a_ready(const pg8::Unit&) const {}
    DI void done(const pg8::Unit&) const {}
};
struct EpiOutProj {
    static constexpr bool PERM = true, AFTER_DRAIN = false;
    const bf16_t* proj; bf16_t* mb;
    DI void operator()(const f32x4 (&acc)[2][2][4][2], const pg8::Unit& u, int wr, int wc, int fr, int fq) const {
        asm volatile("" : "+v"(fr), "+v"(fq));
        const int br = u.pn >> 2, pn = u.pn & 3;
        const bf16_t* gates = proj + 6144 + br * 1024;
#pragma unroll
        for (int ai = 0; ai < 2; ++ai) {
            u32x4 gv[4][2], pv[4][2];
#pragma unroll
            for (int m = 0; m < 4; ++m)
#pragma unroll
                for (int bj = 0; bj < 2; ++bj) {
                    const int row = u.pm * 256 + ai * 128 + wr * 64 + m * 16 + fr, c0 = pn * 256 + bj * 128 + wc * 32 + 8 * fq;
                    gv[m][bj] = *(const u32x4*)(gates + (size_t)row * PJ + c0);
                    pv[m][bj] = br != 0 ? *(const u32x4*)(mb + (size_t)row * DM + c0) : (u32x4){0u, 0u, 0u, 0u};
                }
#pragma unroll
            for (int m = 0; m < 4; ++m)
#pragma unroll
                for (int bj = 0; bj < 2; ++bj) {
                    const int row = u.pm * 256 + ai * 128 + wr * 64 + m * 16 + fr, c0 = pn * 256 + bj * 128 + wc * 32 + 8 * fq;
                    float g[8], p[8], v[8];
                    unpack8(gv[m][bj], g); unpack8(pv[m][bj], p);
#pragma unroll
                    for (int k = 0; k < 4; ++k) { v[k] = acc[ai][bj][m][0][k] * g[k] + p[k]; v[4 + k] = acc[ai][bj][m][1][k] * g[4 + k] + p[4 + k]; }
                    *(u32x4*)(mb + (size_t)row * DM + c0) = pack8(v);
                }
        }
    }
};
struct EpiResid {
    static constexpr bool PERM = true, AFTER_DRAIN = false;
    const float* xi; float* x; bf16_t* xb; float* ssn;
    DI void operator()(const f32x4 (&acc)[2][2][4][2], const pg8::Unit& u, int wr, int wc, int fr, int fq) const {
        asm volatile("" : "+v"(fr), "+v"(fq));
#pragma unroll
        for (int ai = 0; ai < 2; ++ai)
#pragma unroll
            for (int m = 0; m < 4; ++m) {
                const int row = u.pm * 256 + ai * 128 + wr * 64 + m * 16 + fr;
                float sq = 0.f;
#pragma unroll
                for (int bj = 0; bj < 2; ++bj) {
                    const int c0 = u.pn * 256 + bj * 128 + wc * 32 + 8 * fq;
                    float* xp = x + (size_t)row * DM + c0; const float* xip = xi + (size_t)row * DM + c0;
                    const f32x4 a0 = *(const f32x4*)xip, a1 = *(const f32x4*)(xip + 4);
                    float v[8];
#pragma unroll
                    for (int k = 0; k < 4; ++k) { v[k] = acc[ai][bj][m][0][k] + a0[k]; v[4 + k] = acc[ai][bj][m][1][k] + a1[k]; }
#pragma unroll
                    for (int k = 0; k < 8; ++k) sq += v[k] * v[k];
                    *(f32x4*)xp = (f32x4){v[0], v[1], v[2], v[3]}; *(f32x4*)(xp + 4) = (f32x4){v[4], v[5], v[6], v[7]};
                    *(u32x4*)(xb + (size_t)row * DM + c0) = pack8(v);
                }
                sq += __shfl_xor(sq, 16); sq += __shfl_xor(sq, 32);
                if (fq == 0) ssn[(size_t)row * 16 + u.pn * 4 + wc] = sq;
            }
    }
};
struct EpiSwiGLU {
    static constexpr bool PERM = true, AFTER_DRAIN = false;
    bf16_t* hid; const float* rt; const int* pt; int nu;
    DI void operator()(const f32x4 (&acc)[2][2][4][2], const pg8::Unit& u, int wr, int wc, int fr, int fq) const {
        asm volatile("" : "+v"(fr), "+v"(fq));
        const float* rtu = rt + find_slot(pt, nu, u.pm) * 256;
#pragma unroll
        for (int ai = 0; ai < 2; ++ai)
#pragma unroll
            for (int m = 0; m < 4; ++m) {
                const int row = u.pm * 256 + ai * 128 + wr * 64 + m * 16 + fr;
                const float rs = rtu[ai * 128 + wr * 64 + m * 16 + fr];
#pragma unroll
                for (int bj = 0; bj < 2; ++bj) {
                    const int c0 = u.pn * 256 + bj * 128 + wc * 32 + 8 * fq;
                    float v[8];
#pragma unroll
                    for (int k = 0; k < 4; ++k) { v[k] = acc[ai][bj][m][0][k] * rs; v[4 + k] = acc[ai][bj][m][1][k] * rs; }
                    u32x2 w; w.x = pk2(silu(v[0]) * v[1], silu(v[2]) * v[3]); w.y = pk2(silu(v[4]) * v[5], silu(v[6]) * v[7]);
                    *(u32x2*)(hid + (size_t)row * FF + (c0 >> 1)) = w;
                }
            }
    }
};

DI int src_col(int kind, int n) {
    if (kind == 0) {
        if (n < 1024) { const int h = n >> 8, sec = (n >> 7) & 1, p = n & 127, d = (p >> 1) + 64 * (p & 1); return sec * 512 + h * 128 + d; }
        if (n < 2048) return 2048 + (n - 1024);
        if (n < 3072) return 3072 + (n - 2048);
        if (n < 4096) return 4096 + (n - 3072);
        if (n < 5120) return 6144 + (n - 4096);
        if (n < 6144) return 8192 + (n - 5120);
        if (n < 9216) return 9232 + (n - 6144);
        if (n < 9232) return n;
        return -1;
    }
    if (kind == 1) { if (n < 1024) return 1024 + n; if (n < 2048) return 5120 + (n - 1024); return 7168 + (n - 2048); }
    if (kind == 3) return (n >> 1) + FF * (n & 1);
    return n;
}
DI void src_cols8(int kind, int n, int& ca, int& cb, bool& il) {
    if (kind == 0 && n < 1024) { const int h = n >> 8, sec = (n >> 7) & 1, p = n & 127; ca = sec * 512 + h * 128 + (p >> 1); cb = ca + 64; il = true; return; }
    if (kind == 3) { ca = n >> 1; cb = ca + FF; il = true; return; }
    ca = src_col(kind, n); cb = ca + 4; il = false;
}
struct WTile { const float* W; const float* gain; bf16_t* dst; int ldw, K, kind, k0, n0; };
constexpr int T_WIN = 16 * (NPJ / 64), T_WV = 16 * (NVT / 64), T_WO = 16 * 16, T_WUP = 16 * (FF2 / 64), T_WDN = (FF / 64) * 16;
constexpr int T_LAYER = T_WIN + T_WV + 4 * T_WO + T_WUP + T_WDN;
DI WTile wtile_of(const Args& a, int g) {
    WTile t; const int l = g / T_LAYER; int r = g % T_LAYER;
    unsigned char* wb = a.ws + OFF_WB + (size_t)l * LAYER_W;
    int ntn;
    if (r < T_WIN) { t.W = a.in[2] + (size_t)l * DM * INW; t.ldw = INW; t.gain = a.in[1] + l * DM; t.dst = (bf16_t*)(wb + LW_WIN); t.K = DM; t.kind = 0; ntn = NPJ / 64; }
    else if ((r -= T_WIN) < T_WV) { t.W = a.in[2] + (size_t)l * DM * INW; t.ldw = INW; t.gain = a.in[1] + l * DM; t.dst = (bf16_t*)(wb + LW_WV); t.K = DM; t.kind = 1; ntn = NVT / 64; }
    else if ((r -= T_WV) < 3 * T_WO) { const int br = r / T_WO; r %= T_WO; t.W = (br == 0 ? a.in[10] : (br == 1 ? a.in[11] : a.in[12])) + (size_t)l * DM * DM; t.ldw = DM; t.gain = nullptr; t.dst = (bf16_t*)(wb + LW_WO + br * SZ_WO); t.K = DM; t.kind = 2; ntn = 16; }
    else if ((r -= 3 * T_WO) < T_WO) { t.W = a.in[13] + (size_t)l * DM * DM; t.ldw = DM; t.gain = nullptr; t.dst = (bf16_t*)(wb + LW_WOUT); t.K = DM; t.kind = 2; ntn = 16; }
    else if ((r -= T_WO) < T_WUP) { t.W = a.in[15] + (size_t)l * DM * FF2; t.ldw = FF2; t.gain = a.in[14] + l * DM; t.dst = (bf16_t*)(wb + LW_WUP); t.K = DM; t.kind = 3; ntn = FF2 / 64; }
    else { r -= T_WUP; t.W = a.in[16] + (size_t)l * FF * DM; t.ldw = DM; t.gain = nullptr; t.dst = (bf16_t*)(wb + LW_WDN); t.K = FF; t.kind = 2; ntn = 16; }
    t.k0 = (r / ntn) * 64; t.n0 = (r % ntn) * 64;
    return t;
}
DI void prologue(const Args& a, unsigned char* lds, int tid) {
    float* scr = (float*)lds;
    const int G = gridDim.x;
    constexpr int TB = 8;
    const int kk = tid >> 3, nn = (tid & 7) * 8;
    for (int g0 = blockIdx.x; g0 < NL * T_LAYER; g0 += G * TB) {
        f32x4 va[TB], vb[TB]; bool il[TB];
#pragma unroll
        for (int t = 0; t < TB; ++t) {
            const int g = g0 + t * G;
            va[t] = (f32x4){0.f, 0.f, 0.f, 0.f}; vb[t] = va[t]; il[t] = false;
            if (g < NL * T_LAYER) {
                const WTile w = wtile_of(a, g);
                const float gn = w.gain ? w.gain[w.k0 + kk] : 1.f;
                const float* wrow = w.W + (size_t)(w.k0 + kk) * w.ldw;
                int ca, cb; src_cols8(w.kind, w.n0 + nn, ca, cb, il[t]);
                if (ca >= 0) { va[t] = *(const f32x4*)(wrow + ca) * gn; vb[t] = *(const f32x4*)(wrow + cb) * gn; }
            }
        }
#pragma unroll
        for (int t = 0; t < TB; ++t) {
            float* sp = scr + t * (64 * 65) + kk * 65 + nn;
            if (il[t]) { sp[0] = va[t][0]; sp[1] = vb[t][0]; sp[2] = va[t][1]; sp[3] = vb[t][1]; sp[4] = va[t][2]; sp[5] = vb[t][2]; sp[6] = va[t][3]; sp[7] = vb[t][3]; }
            else { sp[0] = va[t][0]; sp[1] = va[t][1]; sp[2] = va[t][2]; sp[3] = va[t][3]; sp[4] = vb[t][0]; sp[5] = vb[t][1]; sp[6] = vb[t][2]; sp[7] = vb[t][3]; }
        }
        __syncthreads();
#pragma unroll
        for (int t = 0; t < TB; ++t) {
            const int g = g0 + t * G;
            if (g < NL * T_LAYER) {
                const WTile w = wtile_of(a, g);
                const int n = tid >> 3, k8 = (tid & 7) * 8;
                const float* sq = scr + t * (64 * 65);
                u32x4 o;
                o.x = pk2(sq[(k8 + 0) * 65 + n], sq[(k8 + 1) * 65 + n]); o.y = pk2(sq[(k8 + 2) * 65 + n], sq[(k8 + 3) * 65 + n]);
                o.z = pk2(sq[(k8 + 4) * 65 + n], sq[(k8 + 5) * 65 + n]); o.w = pk2(sq[(k8 + 6) * 65 + n], sq[(k8 + 7) * 65 + n]);
                *(u32x4*)(w.dst + (size_t)(w.n0 + n) * w.K + w.k0 + k8) = o;
            }
        }
        __syncthreads();
    }
    const int wave = tid >> 6, lane = tid & 63;
    bf16_t* xb = (bf16_t*)(a.ws + OFF_XB); float* ss = (float*)(a.ws + OFF_SS);
    for (int m = blockIdx.x * 8 + wave; m < MT; m += G * 8) {
        const f32x4* xr = (const f32x4*)(a.in[0] + (size_t)m * DM) + lane;
        float s = 0.f;
        f32x4 vx[4];
#pragma unroll
        for (int j = 0; j < 4; ++j) vx[j] = xr[64 * j];
#pragma unroll
        for (int j = 0; j < 4; ++j) {
            const f32x4 v = vx[j];
            s += (v[0] * v[0] + v[1] * v[1]) + (v[2] * v[2] + v[3] * v[3]);
            u32x2 w; w.x = pk2(v[0], v[1]); w.y = pk2(v[2], v[3]);
            ((u32x2*)(xb + (size_t)m * DM))[lane + 64 * j] = w;
        }
#pragma unroll
        for (int o = 1; o < 64; o <<= 1) s += __shfl_xor(s, o);
        if (lane < 16) ss[(size_t)m * 16 + lane] = lane == 0 ? s : 0.f;
    }
    const int gt = blockIdx.x * NTHR + tid, NT = G * NTHR;
    float* cosT = (float*)(a.ws + OFF_COS); float* sinT = (float*)(a.ws + OFF_SIN);
    for (int i = gt; i < SEQ * 64; i += NT) {
        const int t = i >> 6, f = i & 63;
        const float inv = exp2f(-(float)f * (13.287712379549449f / 64.f));
        const float ang = (float)t * inv;
        double rev = (double)ang * 0.15915494309189535; rev -= rint(rev);
        cosT[i] = __builtin_amdgcn_cosf((float)rev); sinT[i] = __builtin_amdgcn_sinf((float)rev);
    }
}

DI void ml_conv8(const bf16_t* proj, const float* cw, const float* cb, int tokb, int t, int ch, float (&o)[8]) {
    { const f32x4 b0 = *(const f32x4*)(cb + ch), b1 = *(const f32x4*)(cb + ch + 4);
#pragma unroll
      for (int k = 0; k < 4; ++k) { o[k] = b0[k]; o[4 + k] = b1[k]; } }
#pragma unroll
    for (int w = 0; w < 5; ++w) {
        const int tt = t + w - 2;
        if (tt >= 0 && tt < SEQ) {
            float x[8]; unpack8(*(const u32x4*)(proj + (size_t)(tokb + tt) * PJ + 4096 + ch), x);
            const f32x4 w0 = *(const f32x4*)(cw + w * 1024 + ch), w1 = *(const f32x4*)(cw + w * 1024 + ch + 4);
#pragma unroll
            for (int k = 0; k < 4; ++k) { o[k] += x[k] * w0[k]; o[4 + k] += x[4 + k] * w1[k]; }
        }
    }
#pragma unroll
    for (int k = 0; k < 8; ++k) o[k] = silu(o[k]);
}

DI void ml_conv4(const bf16_t* proj, const float* cw, const float* cb, int tokb, int t0, int ch, float (&o)[4][8]) {
    float x[8][8];
#pragma unroll
    for (int r = 0; r < 8; ++r) {
        const int tt = t0 + r - 2;
        if (tt >= 0 && tt < SEQ) unpack8(*(const u32x4*)(proj + (size_t)(tokb + tt) * PJ + 4096 + ch), x[r]);
        else {
#pragma unroll
            for (int k = 0; k < 8; ++k) x[r][k] = 0.f;
        }
    }
    { const f32x4 b0 = *(const f32x4*)(cb + ch), b1 = *(const f32x4*)(cb + ch + 4);
#pragma unroll
      for (int i = 0; i < 4; ++i)
#pragma unroll
          for (int k = 0; k < 4; ++k) { o[i][k] = b0[k]; o[i][4 + k] = b1[k]; } }
#pragma unroll
    for (int w = 0; w < 5; ++w) {
        const f32x4 w0 = *(const f32x4*)(cw + w * 1024 + ch), w1 = *(const f32x4*)(cw + w * 1024 + ch + 4);
#pragma unroll
        for (int i = 0; i < 4; ++i)
#pragma unroll
            for (int k = 0; k < 4; ++k) { o[i][k] += x[i + w][k] * w0[k]; o[i][4 + k] += x[i + w][4 + k] * w1[k]; }
    }
#pragma unroll
    for (int i = 0; i < 4; ++i)
#pragma unroll
        for (int k = 0; k < 8; ++k) o[i][k] = silu(o[i][k]);
}

DI void chunk_gates(const Args& a, int l, int mx, int h, int tok0, float* sc, int tid) {
    const int lane = tid & 63, wave = tid >> 6;
    float v = 0.f;
    if (tid < 256) {
        const int dir = tid >> 7, i = tid & 127;
        if (mx == 0) { v = logsig(a.in[4][l * 8 + dir * 4 + h]); sc[512 + tid] = 0.f; }
        else { const float* mg = (const float*)(a.ws + OFF_MG) + (size_t)(tok0 + i) * 16 + dir * 8; v = logsig(mg[4 + h]); sc[512 + tid] = mg[h]; }
    }
    const bool suffix = wave >= 2;
#pragma unroll
    for (int o = 1; o < 64; o <<= 1) {
        const float up = __shfl_up(v, o), dn = __shfl_down(v, o);
        if (suffix) { if (lane + o < 64) v += dn; } else { if (lane >= o) v += up; }
    }
    if (wave < 4 && lane == (suffix ? 0 : 63)) sc[wave] = v;
    __syncthreads();
    if (wave == 1) v += sc[0];
    if (wave == 2) v += sc[3];
    if (tid < 256) sc[256 + tid] = v;
    __syncthreads();
}

DI void mgate_tile(const Args& a, int l, int tile, int lane) {
    asm volatile("" : "+v"(lane));
    const int fr = lane & 15, fq = lane >> 4, tok0 = tile * 16;
    const bf16_t* wg = (const bf16_t*)(a.ws + OFF_WB + (size_t)l * LAYER_W + LW_WIN) + (size_t)(9216 + fr) * DM + fq * 8;
    const bf16_t* xp = (const bf16_t*)(a.ws + OFF_XB) + (size_t)(tok0 + fr) * DM + fq * 8;
    f32x4 acc0 = (f32x4){0.f, 0.f, 0.f, 0.f}, acc1 = acc0;
#pragma unroll
    for (int kb = 0; kb < 4; ++kb) {
        bf16x8 wf[8], xf[8];
#pragma unroll
        for (int k = 0; k < 8; ++k) { wf[k] = *(const bf16x8*)(wg + (kb * 8 + k) * 32); xf[k] = *(const bf16x8*)(xp + (kb * 8 + k) * 32); }
        __builtin_amdgcn_sched_barrier(0);
#pragma unroll
        for (int k = 0; k < 8; k += 2) { acc0 = mfma16(wf[k], xf[k], acc0); acc1 = mfma16(wf[k + 1], xf[k + 1], acc1); }
        __builtin_amdgcn_sched_barrier(0);
    }
    const float rs = row_rstd((const float*)(a.ws + OFF_SS) + (size_t)(2 * l) * MT * 16, tok0 + fr);
    const f32x4 bias = *(const f32x4*)(a.in[8] + l * 16 + fq * 4);
    *(f32x4*)((float*)(a.ws + OFF_MG) + (size_t)(tok0 + fr) * 16 + fq * 4) = (acc0 + acc1) * rs + bias;
}

DI void s1_unit(const Args& a, int l, int mx, int b, int h, int c, unsigned char* lds, int tid) {
    asm volatile("" : "+v"(tid));
    const int wave = tid >> 6, lane = tid & 63, fr = lane & 15, fq = lane >> 4, bh = b * 4 + h;
    const bf16_t* proj = (const bf16_t*)(a.ws + OFF_PROJ); const bf16_t* vt = (const bf16_t*)(a.ws + OFF_VT);
    bf16_t* ST = (bf16_t*)(a.ws + (mx == 0 ? OFF_ST : OFF_X)); float* NS = (float*)(a.ws + OFF_NS); float* cdec = (float*)(a.ws + OFF_CDEC) + mx * 1024;
    float* sc = (float*)(lds + 65536);
    const int tok0 = b * SEQ + c * 128;
    const int vrow = (mx == 0 ? 0 : 2048) + h * 256 + wave * 32;
    bf16x8 vf[4][2];
#pragma unroll
    for (int ks = 0; ks < 4; ++ks)
#pragma unroll
        for (int mt = 0; mt < 2; ++mt) vf[ks][mt] = *(const bf16x8*)(vt + (size_t)(vrow + mt * 16 + fr) * MT + tok0 + ks * 32 + fq * 8);
    chunk_gates(a, l, mx, h, tok0, sc, tid);
    if (tid < 256) {
        const int dir = tid >> 7, j = tid & 127;
        const float tot = dir == 0 ? sc[256 + 127] : sc[256 + 128];
        sc[768 + tid] = __expf(tot - sc[256 + tid] + sc[512 + tid]);
        if (j == 0) cdec[(dir * 16 + bh) * 32 + c] = __expf(tot);
    }
    __syncthreads();
    {
        const int g = tid & 15, j0 = (tid >> 4) * 4;
        float k4[4][8];
        if (mx == 0) {
#pragma unroll
            for (int i = 0; i < 4; ++i) unpack8(*(const u32x4*)(proj + (size_t)(tok0 + j0 + i) * PJ + h * 256 + 128 + g * 8), k4[i]);
        } else ml_conv4(proj, a.in[6] + l * 5 * 1024, a.in[7] + l * 1024, b * SEQ, c * 128 + j0, 512 + h * 128 + g * 8, k4);
        const f32x4 wf = *(const f32x4*)(sc + 768 + j0), wb = *(const f32x4*)(sc + 768 + 128 + j0);
#pragma unroll
        for (int dd = 0; dd < 8; ++dd) {
            u32x2 pf, pb;
            pf.x = pk2(k4[0][dd] * wf[0], k4[1][dd] * wf[1]); pf.y = pk2(k4[2][dd] * wf[2], k4[3][dd] * wf[3]);
            pb.x = pk2(k4[0][dd] * wb[0], k4[1][dd] * wb[1]); pb.y = pk2(k4[2][dd] * wb[2], k4[3][dd] * wb[3]);
            *(u32x2*)(lds + swzt(g * 8 + dd, j0)) = pf;
            *(u32x2*)(lds + 32768 + swzt(g * 8 + dd, j0)) = pb;
        }
    }
    __syncthreads();
#pragma unroll 1
    for (int dir = 0; dir < 2; ++dir) {
        f32x4 acc[2][8];
#pragma unroll
        for (int mt = 0; mt < 2; ++mt)
#pragma unroll
            for (int nt = 0; nt < 8; ++nt) acc[mt][nt] = (f32x4){0.f, 0.f, 0.f, 0.f};
        {
            bf16x8 kf[2][8];
#pragma unroll
            for (int nt = 0; nt < 8; ++nt) kf[0][nt] = *(const bf16x8*)(lds + dir * 32768 + swzt(nt * 16 + fr, fq * 8));
#pragma unroll
            for (int ks = 0; ks < 4; ++ks) {
                if (ks + 1 < 4) {
#pragma unroll
                    for (int nt = 0; nt < 8; ++nt) kf[(ks + 1) & 1][nt] = *(const bf16x8*)(lds + dir * 32768 + swzt(nt * 16 + fr, (ks + 1) * 32 + fq * 8));
                }
                __builtin_amdgcn_sched_barrier(0);
#pragma unroll
                for (int nt = 0; nt < 8; ++nt)
#pragma unroll
                    for (int mt = 0; mt < 2; ++mt) acc[mt][nt] = mfma16(kf[ks & 1][nt], vf[ks][mt], acc[mt][nt]);
                __builtin_amdgcn_sched_barrier(0);
            }
        }
        bf16_t* sp = ST + ((size_t)((dir * 16 + bh) * 32 + c) * 256 + wave * 32) * 128;
#pragma unroll
        for (int mt = 0; mt < 2; ++mt)
#pragma unroll
            for (int nt = 0; nt < 8; ++nt) {
                u32x2 w; w.x = pk2(acc[mt][nt][0], acc[mt][nt][1]); w.y = pk2(acc[mt][nt][2], acc[mt][nt][3]);
                *(u32x2*)(sp + (mt * 16 + fr) * 128 + nt * 16 + fq * 4) = w;
            }
    }
    if (mx == 1 && tid < 256) {
        const int dir = tid >> 7, d = tid & 127;
        float s = 0.f;
#pragma unroll
        for (int j8 = 0; j8 < 16; ++j8) {
            float k8[8]; unpack8(*(const u32x4*)(lds + dir * 32768 + swzt(d, j8 * 8)), k8);
            s += ((k8[0] + k8[1]) + (k8[2] + k8[3])) + ((k8[4] + k8[5]) + (k8[6] + k8[7]));
        }
        NS[((dir * 16 + bh) * 32 + c) * 128 + d] = s;
    }
    __syncthreads();
}

DI void s2_scan(const Args& a, int mx) {
    int tx_ = threadIdx.x; asm volatile("" : "+v"(tx_));
    const int gt = blockIdx.x * NTHR + tx_, NT = gridDim.x * NTHR;
    bf16_t* ST = (bf16_t*)(a.ws + (mx == 0 ? OFF_ST : OFF_X)); float* NS = (float*)(a.ws + OFF_NS); const float* cdec = (const float*)(a.ws + OFF_CDEC) + mx * 1024;
    for (int it = gt; it < 2 * 16 * 8192; it += NT) {
        const int dir = it >> 17, bh = (it >> 13) & 15, p4 = it & 8191;
        bf16_t* base = ST + (size_t)((dir * 16 + bh) * 32) * 32768 + p4 * 4;
        const float* dc = cdec + (dir * 16 + bh) * 32;
        u32x2 v[32]; float dcv[32];
#pragma unroll
        for (int c = 0; c < 32; ++c) { v[c] = *(const u32x2*)(base + (size_t)c * 32768); dcv[c] = dc[c]; }
        float r0 = 0.f, r1 = 0.f, r2 = 0.f, r3 = 0.f;
        if (dir == 0) {
#pragma unroll
            for (int c = 0; c < 32; ++c) {
                u32x2 o; o.x = pk2(r0, r1); o.y = pk2(r2, r3); *(u32x2*)(base + (size_t)c * 32768) = o;
                const float d = dcv[c];
                r0 = d * r0 + bflo(v[c].x); r1 = d * r1 + bfhi(v[c].x); r2 = d * r2 + bflo(v[c].y); r3 = d * r3 + bfhi(v[c].y);
            }
        } else {
#pragma unroll
            for (int c = 31; c >= 0; --c) {
                u32x2 o; o.x = pk2(r0, r1); o.y = pk2(r2, r3); *(u32x2*)(base + (size_t)c * 32768) = o;
                const float d = dcv[c];
                r0 = d * r0 + bflo(v[c].x); r1 = d * r1 + bfhi(v[c].x); r2 = d * r2 + bflo(v[c].y); r3 = d * r3 + bfhi(v[c].y);
            }
        }
    }
    if (mx == 1) {
        for (int it = gt; it < 2 * 16 * 128; it += NT) {
            const int dir = it >> 11, bh = (it >> 7) & 15, d = it & 127;
            float* base = NS + (size_t)((dir * 16 + bh) * 32) * 128 + d;
            const float* dc = cdec + (dir * 16 + bh) * 32;
            float r = 0.f, v[32], dcv[32];
#pragma unroll
            for (int c = 0; c < 32; ++c) { v[c] = base[c * 128]; dcv[c] = dc[c]; }
            if (dir == 0) {
#pragma unroll
                for (int c = 0; c < 32; ++c) { base[c * 128] = r; r = dcv[c] * r + v[c]; }
            } else {
#pragma unroll
                for (int c = 31; c >= 0; --c) { base[c * 128] = r; r = dcv[c] * r + v[c]; }
            }
        }
    }
}

DI void s3_unit(const Args& a, int l, int mx, int b, int h, int c, unsigned char* lds, int tid) {
    asm volatile("" : "+v"(tid));
    const int wave = tid >> 6, lane = tid & 63, fr = lane & 15, fq = lane >> 4, bh = b * 4 + h;
    bf16_t* proj = (bf16_t*)(a.ws + OFF_PROJ); const bf16_t* vt = (const bf16_t*)(a.ws + OFF_VT);
    const bf16_t* ST = (const bf16_t*)(a.ws + (mx == 0 ? OFF_ST : OFF_X)); const float* NS = (const float*)(a.ws + OFF_NS);
    float* sc = (float*)(lds + 131072);
    const int tok0 = b * SEQ + c * 128;
    if (mx == 0) {
        u32x4 qw[4], kw[4];
#pragma unroll
        for (int k = 0; k < 4; ++k) { const bf16_t* p = proj + (size_t)(tok0 + (tid >> 4) + 32 * k) * PJ + h * 256 + (tid & 15) * 8; qw[k] = *(const u32x4*)p; kw[k] = *(const u32x4*)(p + 128); }
#pragma unroll
        for (int k = 0; k < 4; ++k) { *(u32x4*)(lds + swz((tid >> 4) + 32 * k, (tid & 15) * 8)) = qw[k]; *(u32x4*)(lds + 32768 + swz((tid >> 4) + 32 * k, (tid & 15) * 8)) = kw[k]; }
    } else {
        const int g = tid & 15, j0 = (tid >> 4) * 4;
        float v4[4][8];
        ml_conv4(proj, a.in[6] + l * 5 * 1024, a.in[7] + l * 1024, b * SEQ, c * 128 + j0, h * 128 + g * 8, v4);
#pragma unroll
        for (int i = 0; i < 4; ++i) {
#pragma unroll
            for (int k = 0; k < 8; ++k) v4[i][k] *= 0.08838834764831845f;
            *(u32x4*)(lds + swz(j0 + i, g * 8)) = pack8(v4[i]);
        }
        ml_conv4(proj, a.in[6] + l * 5 * 1024, a.in[7] + l * 1024, b * SEQ, c * 128 + j0, 512 + h * 128 + g * 8, v4);
#pragma unroll
        for (int i = 0; i < 4; ++i) *(u32x4*)(lds + 32768 + swz(j0 + i, g * 8)) = pack8(v4[i]);
    }
    const int vrow = (mx == 0 ? 0 : 2048) + h * 256 + wave * 32;
    bf16x8 rfr[2][4][2], vfr[4][2];
    {
        const bf16_t* Vb = vt + (size_t)vrow * MT + tok0;
#pragma unroll
        for (int ks = 0; ks < 4; ++ks) { vfr[ks][0] = *(const bf16x8*)(Vb + (size_t)(fr) * MT + ks * 32 + fq * 8); vfr[ks][1] = *(const bf16x8*)(Vb + (size_t)(16 + fr) * MT + ks * 32 + fq * 8); }
    }
    if (mx == 1 && tid < 256) sc[3328 + tid] = NS[(size_t)(((tid >> 7) * 16 + bh) * 32 + c) * 128 + (tid & 127)];
    chunk_gates(a, l, mx, h, tok0, sc, tid);
    if (mx == 1 && tid < 256) {
        const int dir = tid >> 7, i = tid & 127;
        const float* np = sc + 3328 + dir * 128;
        float s = 0.f;
#pragma unroll 8
        for (int d8 = 0; d8 < 16; ++d8) {
            float q8[8]; unpack8(*(const u32x4*)(lds + swz(i, d8 * 8)), q8);
            const f32x4 n0 = *(const f32x4*)(np + d8 * 8), n1 = *(const f32x4*)(np + d8 * 8 + 4);
#pragma unroll
            for (int k = 0; k < 4; ++k) s += q8[k] * n0[k] + q8[4 + k] * n1[k];
        }
        sc[768 + tid] = s;
    }
    f32x4 sacc[8];
#pragma unroll
    for (int nt = 0; nt < 8; ++nt) sacc[nt] = (f32x4){0.f, 0.f, 0.f, 0.f};
    {
        bf16x8 kf[2][8], qf[2];
        qf[0] = *(const bf16x8*)(lds + swz(wave * 16 + fr, fq * 8));
#pragma unroll
        for (int nt = 0; nt < 8; ++nt) kf[0][nt] = *(const bf16x8*)(lds + 32768 + swz(nt * 16 + fr, fq * 8));
#pragma unroll
        for (int ks = 0; ks < 4; ++ks) {
            if (ks + 1 < 4) {
                qf[(ks + 1) & 1] = *(const bf16x8*)(lds + swz(wave * 16 + fr, (ks + 1) * 32 + fq * 8));
#pragma unroll
                for (int nt = 0; nt < 8; ++nt) kf[(ks + 1) & 1][nt] = *(const bf16x8*)(lds + 32768 + swz(nt * 16 + fr, (ks + 1) * 32 + fq * 8));
            }
            __builtin_amdgcn_sched_barrier(0);
#pragma unroll
            for (int nt = 0; nt < 8; ++nt) sacc[nt] = mfma16(kf[ks & 1][nt], qf[ks & 1], sacc[nt]);
            __builtin_amdgcn_sched_barrier(0);
        }
    }
    __syncthreads();
#pragma unroll
    for (int dir = 0; dir < 2; ++dir) {
        const float* A = sc + 256 + dir * 128; const float* IO = sc + 512 + dir * 128;
        const int i = wave * 16 + fr; const float Ai = A[i]; float rsum = 0.f;
        float p[8][4];
#pragma unroll
        for (int nt = 0; nt < 8; ++nt) {
            if (dir == 0 ? (nt > wave) : (nt < wave)) {
#pragma unroll
                for (int jj = 0; jj < 4; ++jj) p[nt][jj] = 0.f;
            } else {
                const f32x4 Aj = *(const f32x4*)(A + nt * 16 + fq * 4), Ij = *(const f32x4*)(IO + nt * 16 + fq * 4);
#pragma unroll
                for (int jj = 0; jj < 4; ++jj) {
                    const int j = nt * 16 + fq * 4 + jj;
                    const bool ok = dir == 0 ? (j <= i) : (mx == 0 ? (j > i) : (j >= i));
                    const float w = ok ? __expf(Ai - Aj[jj] + Ij[jj]) : 0.f;
                    p[nt][jj] = sacc[nt][jj] * w; rsum += p[nt][jj];
                }
            }
        }
        rsum += __shfl_xor(rsum, 16); rsum += __shfl_xor(rsum, 32);
        const float e = __expf(Ai); float inv = 1.f;
        if (mx == 1) { const float den = rsum + e * sc[768 + dir * 128 + i]; inv = 1.f / fmaxf(fabsf(den), 1.f); }
        if (fq == 0) sc[1024 + dir * 128 + i] = e * inv;
#pragma unroll
        for (int nt = 0; nt < 8; ++nt) {
            u32x2 w2; w2.x = pk2(p[nt][0] * inv, p[nt][1] * inv); w2.y = pk2(p[nt][2] * inv, p[nt][3] * inv);
            *(u32x2*)(lds + 32768 + dir * 32768 + swz(i, nt * 16 + fq * 4)) = w2;
        }
    }
    __syncthreads();
#pragma unroll
    for (int dir = 0; dir < 2; ++dir) {
        const bf16_t* Rb = ST + ((size_t)((dir * 16 + bh) * 32 + c) * 256 + wave * 32) * 128;
#pragma unroll
        for (int ks = 0; ks < 4; ++ks) { rfr[dir][ks][0] = *(const bf16x8*)(Rb + (fr) * 128 + ks * 32 + fq * 8); rfr[dir][ks][1] = *(const bf16x8*)(Rb + (16 + fr) * 128 + ks * 32 + fq * 8); }
    }
    {
        u32x4 qr[4]; float ff[4], fb[4];
#pragma unroll
        for (int k4 = 0; k4 < 4; ++k4) { const int j = (tid >> 4) + 32 * k4; qr[k4] = *(const u32x4*)(lds + swz(j, (tid & 15) * 8)); ff[k4] = sc[1024 + j]; fb[k4] = sc[1024 + 128 + j]; }
#pragma unroll
        for (int k4 = 0; k4 < 4; ++k4) {
            const int j = (tid >> 4) + 32 * k4;
            float q8[8], qa[8], qb[8]; unpack8(qr[k4], q8);
#pragma unroll
            for (int k = 0; k < 8; ++k) { qa[k] = q8[k] * ff[k4]; qb[k] = q8[k] * fb[k4]; }
            *(u32x4*)(lds + swz(j, (tid & 15) * 8)) = pack8(qa);
            *(u32x4*)(lds + 98304 + swz(j, (tid & 15) * 8)) = pack8(qb);
        }
    }
    __syncthreads();
    f32x4 hs[8][2];
#pragma unroll
    for (int mt = 0; mt < 8; ++mt) { hs[mt][0] = (f32x4){0.f, 0.f, 0.f, 0.f}; hs[mt][1] = (f32x4){0.f, 0.f, 0.f, 0.f}; }
    {
        bf16x8 fa[2][8];
#pragma unroll
        for (int mt = 0; mt < 8; ++mt) fa[0][mt] = *(const bf16x8*)(lds + swz(mt * 16 + fr, fq * 8));
#pragma unroll
        for (int st = 0; st < 16; ++st) {
            const int dir = st >> 3, intra = (st >> 2) & 1, ks = st & 3;
            if (st + 1 < 16) {
                const int nd = (st + 1) >> 3, ni = ((st + 1) >> 2) & 1, nk = (st + 1) & 3;
                const unsigned char* T = ni ? (lds + 32768 + nd * 32768) : (lds + nd * 98304);
#pragma unroll
                for (int mt = 0; mt < 8; ++mt) fa[(st + 1) & 1][mt] = *(const bf16x8*)(T + swz(mt * 16 + fr, nk * 32 + fq * 8));
            }
            __builtin_amdgcn_sched_barrier(0);
            const bf16x8 b0 = intra ? vfr[ks][0] : rfr[dir][ks][0], b1 = intra ? vfr[ks][1] : rfr[dir][ks][1];
#pragma unroll
            for (int mt = 0; mt < 8; ++mt) { hs[mt][0] = mfma16(b0, fa[st & 1][mt], hs[mt][0]); hs[mt][1] = mfma16(b1, fa[st & 1][mt], hs[mt][1]); }
            __builtin_amdgcn_sched_barrier(0);
        }
    }
    const int gcol = (mx == 0 ? 1024 : 5120) + h * 256 + wave * 32;
    u32x2 gwv[8][2];
#pragma unroll
    for (int mt = 0; mt < 8; ++mt)
#pragma unroll
        for (int nt = 0; nt < 2; ++nt) gwv[mt][nt] = *(const u32x2*)(proj + (size_t)(tok0 + mt * 16 + fr) * PJ + gcol + nt * 16 + fq * 4);
    float* red1 = sc + 1280; float* red2 = sc + 2304;
#pragma unroll
    for (int mt = 0; mt < 8; ++mt) {
        float s1 = 0.f, s2 = 0.f;
#pragma unroll
        for (int nt = 0; nt < 2; ++nt)
#pragma unroll
            for (int jj = 0; jj < 4; ++jj) { const float v = hs[mt][nt][jj]; s1 += v; s2 += v * v; }
        s1 += __shfl_xor(s1, 16); s1 += __shfl_xor(s1, 32); s2 += __shfl_xor(s2, 16); s2 += __shfl_xor(s2, 32);
        if (fq == 0) { red1[(mt * 16 + fr) * 8 + wave] = s1; red2[(mt * 16 + fr) * 8 + wave] = s2; }
    }
    __syncthreads();
    const float* ng = a.in[9] + l * 1024 + h * 256 + wave * 32;
#pragma unroll
    for (int mt = 0; mt < 8; ++mt) {
        const int i = mt * 16 + fr;
        const f32x4 ra = *(const f32x4*)(red1 + i * 8), rb = *(const f32x4*)(red1 + i * 8 + 4), qa = *(const f32x4*)(red2 + i * 8), qb = *(const f32x4*)(red2 + i * 8 + 4);
        const float S1 = ((ra[0] + ra[1]) + (ra[2] + ra[3])) + ((rb[0] + rb[1]) + (rb[2] + rb[3])), S2 = ((qa[0] + qa[1]) + (qa[2] + qa[3])) + ((qb[0] + qb[1]) + (qb[2] + qb[3]));
        const float mean = S1 * (1.f / 256.f), var = fmaxf(S2 * (1.f / 256.f) - mean * mean, 0.f), rstd = rsqrtf(var + EPSF);
#pragma unroll
        for (int nt = 0; nt < 2; ++nt) {
            const int e0 = nt * 16 + fq * 4;
            bf16_t* gp = proj + (size_t)(tok0 + i) * PJ + gcol + e0;
            const u32x2 gw = gwv[mt][nt];
            f32x4 y = (hs[mt][nt] - mean) * rstd;
            if (mx == 1) { const f32x4 g4 = *(const f32x4*)(ng + e0); y = y * g4; }
            u32x2 w; w.x = pk2(y[0] * bflo(gw.x), y[1] * bfhi(gw.x)); w.y = pk2(y[2] * bflo(gw.y), y[3] * bfhi(gw.y));
            *(u32x2*)gp = w;
        }
    }
    __syncthreads();
}

constexpr int NA_KP = 144, NA_VP = 136;
constexpr int NA_VOFF = 9 * 64 * NA_KP, NA_BOFF = NA_VOFF + 9 * 64 * NA_VP;
static_assert(NA_BOFF + 465 * 4 <= LDS_BYTES - 64, "NA LDS map");
struct NaStage { u32x4 kv[9], vv[9]; float bias; };
DI void na_load(const Args& a, int l, int u, int tid, NaStage& st) {
    const bf16_t* proj = (const bf16_t*)(a.ws + OFF_PROJ); const bf16_t* vt = (const bf16_t*)(a.ws + OFF_VT);
    const int rp = u & 31, head = (u >> 5) & 15, b = u >> 9, r0 = rp * 2, rs0 = min(max(r0 - 4, 0), 56);
    const int sub = tid & 7, rowi = tid >> 3, nkr = (rs0 + 8 <= 63) ? 9 : 8;
#pragma unroll
    for (int kr = 0; kr < 9; ++kr) if (kr < nkr) {
        st.kv[kr] = *(const u32x4*)(proj + (size_t)(b * SEQ + (rs0 + kr) * 64 + rowi) * PJ + 3072 + head * 64 + sub * 8);
        st.vv[kr] = *(const u32x4*)(vt + (size_t)(1024 + head * 64 + rowi) * MT + b * SEQ + (rs0 + kr) * 64 + sub * 8);
    }
    st.bias = tid < 465 ? a.in[5][(size_t)(l * 16 + head) * 465 + tid] : 0.f;
}
DI void na_store(int u, int tid, const NaStage& st, unsigned char* lds) {
    const int rp = u & 31, r0 = rp * 2, rs0 = min(max(r0 - 4, 0), 56);
    const int sub = tid & 7, rowi = tid >> 3, nkr = (rs0 + 8 <= 63) ? 9 : 8;
#pragma unroll
    for (int kr = 0; kr < 9; ++kr) if (kr < nkr) {
        *(u32x4*)(lds + (kr * 64 + rowi) * NA_KP + sub * 16) = st.kv[kr];
        *(u32x2*)(lds + NA_VOFF + (kr * 64 + rowi) * NA_VP + sub * 16) = (u32x2){st.vv[kr].x, st.vv[kr].y};
        *(u32x2*)(lds + NA_VOFF + (kr * 64 + rowi) * NA_VP + sub * 16 + 8) = (u32x2){st.vv[kr].z, st.vv[kr].w};
    }
    if (tid < 465) ((float*)(lds + NA_BOFF))[tid] = st.bias;
}
DI void na_phase(const Args& a, int l, unsigned char* lds, int tid, int xcc, int xrank, bool xo) {
    asm volatile("" : "+v"(tid));
    const int G = gridDim.x;
    bf16_t* proj = (bf16_t*)(a.ws + OFF_PROJ);
    const int wave = tid >> 6, lane = tid & 63, fr = lane & 15, fq = lane >> 4;
    NaStage st;
    const int ubase = xo ? (xcc * 8) * 32 + xrank : blockIdx.x, ustep = xo ? 32 : G, ucnt = xo ? 8 : (2048 - (int)blockIdx.x + G - 1) / G;
    if (ucnt > 0) na_load(a, l, ubase, tid, st);
#pragma unroll 1
    for (int ui = 0; ui < ucnt; ++ui) {
    const int u = ubase + ui * ustep;
    const int rp = u & 31, head = (u >> 5) & 15, b = u >> 9, r0 = rp * 2;
    const int rs0 = min(max(r0 - 4, 0), 56);
    const int r = r0 + (wave >> 2), cb = wave & 3, rs = min(max(r - 4, 0), 56), kro = rs - rs0;
    const int kc0 = cb == 0 ? 0 : (cb == 1 ? 8 : (cb == 2 ? 24 : 32));
    bf16_t* qp = proj + (size_t)(b * SEQ + r * 64 + cb * 16 + fr) * PJ + 2048 + head * 64;
    const bf16x8 qf0 = *(const bf16x8*)(qp + fq * 8), qf1 = *(const bf16x8*)(qp + 32 + fq * 8);
    na_store(u, tid, st, lds);
    if (ui + 1 < ucnt) na_load(a, l, u + ustep, tid, st);
    __syncthreads();
    f32x4 s[16];
    {
        bf16x8 kf[2][8];
#pragma unroll
        for (int t = 0; t < 4; ++t) {
            const unsigned char* kp = lds + ((kro + (t >> 1)) * 64 + kc0 + (t & 1) * 16 + fr) * NA_KP + fq * 16;
            kf[0][2 * t] = *(const bf16x8*)kp; kf[0][2 * t + 1] = *(const bf16x8*)(kp + 64);
        }
#pragma unroll
        for (int bt = 0; bt < 4; ++bt) {
            if (bt + 1 < 4) {
#pragma unroll
                for (int t = 0; t < 4; ++t) {
                    const int nt = (bt + 1) * 4 + t;
                    const unsigned char* kp = lds + ((kro + (nt >> 1)) * 64 + kc0 + (nt & 1) * 16 + fr) * NA_KP + fq * 16;
                    kf[(bt + 1) & 1][2 * t] = *(const bf16x8*)kp; kf[(bt + 1) & 1][2 * t + 1] = *(const bf16x8*)(kp + 64);
                }
            }
            __builtin_amdgcn_sched_barrier(0);
#pragma unroll
            for (int t = 0; t < 4; ++t) {
                f32x4 z = (f32x4){0.f, 0.f, 0.f, 0.f};
                z = mfma16(kf[bt & 1][2 * t], qf0, z); z = mfma16(kf[bt & 1][2 * t + 1], qf1, z);
                s[bt * 4 + t] = z;
            }
            __builtin_amdgcn_sched_barrier(0);
        }
    }
    const int cq = cb * 16 + fr, sc0 = min(max(cq - 8, 0), 48);
    const float* rpl = (const float*)(lds + NA_BOFF);
    float mxv = -1e30f;
#pragma unroll
    for (int nt = 0; nt < 16; ++nt)
#pragma unroll
        for (int jj = 0; jj < 4; ++jj) {
            const int kc = kc0 + (nt & 1) * 16 + fq * 4 + jj;
            const bool ok = (kc >= sc0) && (kc < sc0 + 16);
            const int rr = rs + (nt >> 1) - r + 7, cr = min(max(kc - cq + 15, 0), 30);
            const float v = ok ? s[nt][jj] + rpl[rr * 31 + cr] : -1e30f;
            s[nt][jj] = v; mxv = fmaxf(mxv, v);
        }
    mxv = fmaxf(mxv, __shfl_xor(mxv, 16)); mxv = fmaxf(mxv, __shfl_xor(mxv, 32));
    float sum = 0.f;
#pragma unroll
    for (int nt = 0; nt < 16; ++nt)
#pragma unroll
        for (int jj = 0; jj < 4; ++jj) { const float p = __expf(s[nt][jj] - mxv); s[nt][jj] = p; sum += p; }
    sum += __shfl_xor(sum, 16); sum += __shfl_xor(sum, 32);
    const float inv = 1.f / sum;
    f32x4 o[4];
#pragma unroll
    for (int et = 0; et < 4; ++et) o[et] = (f32x4){0.f, 0.f, 0.f, 0.f};
    {
        u32x4 vw[2][4];
#pragma unroll
        for (int et = 0; et < 4; ++et) {
            const unsigned char* vp = lds + NA_VOFF + ((kro + 0) * 64 + et * 16 + fr) * NA_VP + (kc0 + fq * 4) * 2;
            const u32x2 lo = *(const u32x2*)vp, hi = *(const u32x2*)(vp + 32);
            vw[0][et].x = lo.x; vw[0][et].y = lo.y; vw[0][et].z = hi.x; vw[0][et].w = hi.y;
        }
#pragma unroll
        for (int ks = 0; ks < 8; ++ks) {
            if (ks + 1 < 8) {
#pragma unroll
                for (int et = 0; et < 4; ++et) {
                    const unsigned char* vp = lds + NA_VOFF + ((kro + ks + 1) * 64 + et * 16 + fr) * NA_VP + (kc0 + fq * 4) * 2;
                    const u32x2 lo = *(const u32x2*)vp, hi = *(const u32x2*)(vp + 32);
                    vw[(ks + 1) & 1][et].x = lo.x; vw[(ks + 1) & 1][et].y = lo.y; vw[(ks + 1) & 1][et].z = hi.x; vw[(ks + 1) & 1][et].w = hi.y;
                }
            }
            u32x4 pw; pw.x = pk2(s[2 * ks][0], s[2 * ks][1]); pw.y = pk2(s[2 * ks][2], s[2 * ks][3]); pw.z = pk2(s[2 * ks + 1][0], s[2 * ks + 1][1]); pw.w = pk2(s[2 * ks + 1][2], s[2 * ks + 1][3]);
            const bf16x8 pf = __builtin_bit_cast(bf16x8, pw);
            __builtin_amdgcn_sched_barrier(0);
#pragma unroll
            for (int et = 0; et < 4; ++et) o[et] = mfma16(__builtin_bit_cast(bf16x8, vw[ks & 1][et]), pf, o[et]);
            __builtin_amdgcn_sched_barrier(0);
        }
    }
#pragma unroll
    for (int et = 0; et < 4; ++et) {
        u32x2 w; w.x = pk2(o[et][0] * inv, o[et][1] * inv); w.y = pk2(o[et][2] * inv, o[et][3] * inv);
        *(u32x2*)(qp + et * 16 + fq * 4) = w;
    }
    __syncthreads();
    }
}

DI int opaque_bx() { int bx = blockIdx.x; asm volatile("" : "+s"(bx)); return bx; }
template <bool BYCOL, int NU>
DI void fill_rstd(const pg8::StaticOrder& S, const float* ssp, float* rt, int* pt, int tid) {
    __syncthreads();
    constexpr int NIT = (NU * 256 + NTHR - 1) / NTHR;
    float v[NIT];
#pragma unroll
    for (int k = 0; k < NIT; ++k) {
        const int idx = tid + k * NTHR, i = __builtin_amdgcn_readfirstlane(idx >> 8), t = idx & 255;
        pg8::Unit uu; const bool ok = (i < NU) && S.next(i, uu); const int tile = BYCOL ? uu.pn : uu.pm;
        v[k] = ok ? row_rstd(ssp, tile * 256 + t) : 0.f;
        if (t == 0 && i < NU) pt[i] = ok ? tile : -1;
    }
    asm volatile("" : "+v"(tid));
#pragma unroll
    for (int k = 0; k < NIT; ++k) { const int idx = tid + k * NTHR; if (idx < NU * 256) rt[idx] = v[k]; }
    __syncthreads();
}
#define LAS __attribute__((address_space(3)))
#define XB_TMO      128
#define XB_XCNT(j)  (256  + 64 * (j))
#define XB_XSUB(j)  (1280 + 64 * (j))
#define XB_XGEN(j)  (2304 + 64 * (j))
#define XB_TOP      3328
#define XB_TOPGEN   3392
#define XCD_BAR_WORDS 3456
#define XB_SPIN_CAP (1u << 18)

__device__ __forceinline__ unsigned xb_ld(unsigned* p)              { return __hip_atomic_load(p, __ATOMIC_RELAXED, __HIP_MEMORY_SCOPE_AGENT); }
__device__ __forceinline__ unsigned xb_add(unsigned* p, unsigned v) { return __hip_atomic_fetch_add(p, v, __ATOMIC_RELAXED, __HIP_MEMORY_SCOPE_AGENT); }
__device__ __forceinline__ unsigned xb_xcc_id() { return (unsigned)__builtin_amdgcn_s_getreg((3 << 11) | 20) & 0xFu; }
#define XB_SPIN(cond, bar) do { unsigned _sp = 0; while (cond) { __builtin_amdgcn_s_sleep(1); \
    if ((++_sp & 255u) == 0u) { if (xb_ld(&(bar)[XB_TMO])) break; if (_sp > XB_SPIN_CAP) { atomicAdd(&(bar)[XB_TMO], 1u); break; } } } } while (0)

struct XcdBarrier {
    unsigned* bar; unsigned x;
    volatile LAS unsigned* st;
};

__device__ __forceinline__ XcdBarrier xcd_barrier_post(unsigned* bar, volatile LAS unsigned* st) {
    XcdBarrier b; b.bar = bar; b.x = xb_xcc_id(); b.st = st;
    if (threadIdx.x == 0) (void)xb_add(&bar[XB_XCNT(b.x)], 1u);
    return b;
}
__device__ __forceinline__ void xcd_barrier_complete(unsigned* bar, unsigned x, unsigned& nloc, unsigned& nx) {
    const unsigned G = gridDim.x * gridDim.y * gridDim.z;
    unsigned sum, cnt, mine, sp = 0u;
    for (;;) {
        sum = 0u; cnt = 0u; mine = 0u;
#pragma unroll
        for (unsigned j = 0; j < 16; ++j) { const unsigned c = xb_ld(&bar[XB_XCNT(j)]); sum += c; cnt += (c > 0u) ? 1u : 0u; mine = (j == x) ? c : mine; }
        if (sum == G) break;
        __builtin_amdgcn_s_sleep(1);
        if ((++sp & 255u) == 0u) { if (xb_ld(&bar[XB_TMO])) break; if (sp > XB_SPIN_CAP) { atomicAdd(&bar[XB_TMO], 1u); break; } }
    }
    nloc = mine > 0u ? mine : 1u; nx = cnt > 0u ? cnt : 1u;
}

__device__ __forceinline__ void xcd_barrier(const XcdBarrier& b) {
    asm volatile("s_waitcnt vmcnt(0)" ::: "memory");
    __syncthreads();
    if (threadIdx.x == 0) {
        unsigned* bar = b.bar;
        __builtin_amdgcn_s_waitcnt(0);
        unsigned nloc = b.st[0], nx = b.st[1];
        if (nloc == 0u) { xcd_barrier_complete(bar, b.x, nloc, nx); b.st[0] = nloc; b.st[1] = nx; }
        const unsigned old = xb_add(&bar[XB_XSUB(b.x)], 1u);
        const unsigned gen = old / nloc;
        if (old + 1u == (gen + 1u) * nloc) {
            __builtin_amdgcn_fence(__ATOMIC_RELEASE, "agent");
            asm volatile("s_waitcnt vmcnt(0)" ::: "memory");
            const unsigned og = xb_add(&bar[XB_TOP], 1u);
            const unsigned tg = og / nx;
            if (og + 1u == (tg + 1u) * nx) xb_add(&bar[XB_TOPGEN], 1u);
            else XB_SPIN(xb_ld(&bar[XB_TOPGEN]) == tg, bar);
            __builtin_amdgcn_fence(__ATOMIC_ACQUIRE, "agent");
            xb_add(&bar[XB_XGEN(b.x)], 1u);
            asm volatile("s_waitcnt vmcnt(0)" ::: "memory");
        } else {
            XB_SPIN(xb_ld(&bar[XB_XGEN(b.x)]) == gen, bar);
            __builtin_amdgcn_fence(__ATOMIC_ACQUIRE, "agent");
            asm volatile("s_waitcnt vmcnt(0)" ::: "memory");
        }
    }
    __syncthreads();
}

#define ARGS_HERE(name) int z_##name = 0; asm volatile("" : "+s"(z_##name)); const Args& name = *(const Args*)((const char*)__builtin_amdgcn_kernarg_segment_ptr() + z_##name)
__global__ void __launch_bounds__(NTHR, 2) mega_fwd(Args a_unused) {
    extern __shared__ __attribute__((aligned(16))) unsigned char lds[];
    cg::grid_group grid = cg::this_grid();
    const int tid = threadIdx.x, G = gridDim.x;
    PG8_LAS unsigned char* lds3 = (PG8_LAS unsigned char*)lds;
    volatile LAS unsigned* bst = (volatile LAS unsigned*)(lds3 + LDS_BYTES - 64);
    if (tid < 8) bst[tid] = 0u;
    __syncthreads();
    XcdBarrier bar;
    { ARGS_HERE(a); bar = xcd_barrier_post((unsigned*)(a.ws + OFF_BAR), bst);
      if (tid == 0) { const unsigned xc = xb_xcc_id(); bst[2] = xc; bst[3] = xb_add((unsigned*)(a.ws + OFF_BAR) + 3584 + 32 * xc, 1u); } }
#define GRID_SYNC() xcd_barrier(bar)
    { ARGS_HERE(a); prologue(a, lds, tid); }
    grid.sync();
    {
        ARGS_HERE(a);
        if (tid == 0) { unsigned okc = (G == 256) ? 1u : 0u; for (int j = 0; j < 16; ++j) { const unsigned c = xb_ld((unsigned*)(a.ws + OFF_BAR) + 3584 + 32 * j); if (c != (j < 8 ? 32u : 0u)) okc = 0u; } bst[4] = okc; }
        __syncthreads();
    }
#pragma unroll 1
    for (int l = 0; l < NL; ++l) {
        {
            ARGS_HERE(a);
            const unsigned char* wb = a.ws + OFF_WB + (size_t)l * LAYER_W; const bf16_t* xb = (const bf16_t*)(a.ws + OFF_XB); const float* ss = (const float*)(a.ws + OFF_SS) + (size_t)(2 * l) * MT * 16;
            float* rt = (float*)(lds + 131072); int* pt = (int*)(lds + 131072 + 12288);
            {
                pg8::Gemm g{xb, (const bf16_t*)(wb + LW_WIN), MT, PJ, DM, DM, DM}; pg8::StaticOrder S; S.init(MT, PJ, G, opaque_bx());
                fill_rstd<false, 9>(S, ss, rt, pt, tid);
                EpiInProj E{(bf16_t*)(a.ws + OFF_PROJ), rt, pt, 9, (const float*)(a.ws + OFF_COS), (const float*)(a.ws + OFF_SIN), a.in[3] + l * 3072};
                pg8::gemm_phase<EpiInProj, pg8::StaticOrder, true, true>(lds3, g, S, E);
            }
            {
                pg8::Gemm g{(const bf16_t*)(wb + LW_WV), xb, NVT, MT, DM, DM, DM}; pg8::StaticOrder S; S.init(NVT, MT, G, opaque_bx()); S.wgm = 8;
                fill_rstd<true, 3>(S, ss, rt, pt, tid);
                EpiVt E{(bf16_t*)(a.ws + OFF_VT), rt, pt};
                pg8::gemm_phase<EpiVt, pg8::StaticOrder, true, true>(lds3, g, S, E);
                int tw = tid; asm volatile("" : "+v"(tw));
                if ((tw >> 6) < 4) { for (int t16 = blockIdx.x * 4 + (tw >> 6); t16 < MT / 16; t16 += G * 4) mgate_tile(a, l, t16, tw & 63); }
            }
        }
        GRID_SYNC();
        {
            ARGS_HERE(a);
            na_phase(a, l, lds, tid, (int)bst[2], (int)bst[3], bst[4] != 0u);
#pragma unroll 1
            for (int k = 0; k * G + (int)blockIdx.x < 1024; ++k) {
                int mxu, bu, hu, cu;
                if (G == 256) {
                    const int x = blockIdx.x & 7, q = (blockIdx.x >> 3) * 2 + (k & 1);
                    mxu = k >> 1; bu = x >> 1; hu = q >> 4; cu = (x & 1) * 16 + (q & 15);
                } else { const int u = k * G + blockIdx.x; mxu = u >> 9; bu = (u >> 7) & 3; hu = (u >> 5) & 3; cu = u & 31; }
                s1_unit(a, l, mxu, bu, hu, cu, lds, tid);
            }
        }
        GRID_SYNC();
        { ARGS_HERE(a); s2_scan(a, 0); s2_scan(a, 1); }
        GRID_SYNC();
        {
            ARGS_HERE(a);
#pragma unroll 1
            for (int k = 0; k * G + (int)blockIdx.x < 1024; ++k) {
                int mxu, bu, hu, cu;
                if (G == 256) {
                    const int x = blockIdx.x & 7, q = (blockIdx.x >> 3) * 2 + (k & 1);
                    mxu = k >> 1; bu = x >> 1; hu = q >> 4; cu = (x & 1) * 16 + (q & 15);
                } else { const int u = k * G + blockIdx.x; mxu = u >> 9; bu = (u >> 7) & 3; hu = (u >> 5) & 3; cu = u & 31; }
                s3_unit(a, l, mxu, bu, hu, cu, lds, tid);
            }
        }
        GRID_SYNC();
        {
            ARGS_HERE(a);
            const unsigned char* wb = a.ws + OFF_WB + (size_t)l * LAYER_W; const bf16_t* proj = (const bf16_t*)(a.ws + OFF_PROJ);
            pg8::Gemm g{proj, (const bf16_t*)(wb + LW_WO), MT, 3 * DM, DM, PJ, DM}; OutProjOrder S; S.S0.init(MT, DM, G, opaque_bx());
            EpiOutProj E{proj, (bf16_t*)(a.ws + OFF_MB)};
            pg8::gemm_phase<EpiOutProj, OutProjOrder, true, true>(lds3, g, S, E);
        }
        GRID_SYNC();
#pragma unroll 1
        for (int ph = 0; ph < 3; ++ph) {
            ARGS_HERE(a);
            const unsigned char* wb = a.ws + OFF_WB + (size_t)l * LAYER_W;
            float* xw = a.out; bf16_t* xb = (bf16_t*)(a.ws + OFF_XB); float* ss = (float*)(a.ws + OFF_SS);
            if (ph != 1) {
                pg8::Gemm g{(const bf16_t*)(a.ws + (ph == 0 ? OFF_MB : OFF_HID)), (const bf16_t*)(wb + (ph == 0 ? LW_WOUT : LW_WDN)), MT, DM, ph == 0 ? DM : FF, ph == 0 ? DM : FF, ph == 0 ? DM : FF};
                pg8::StaticOrder S; S.init(MT, DM, G, opaque_bx());
#ifdef DUP_RESID
                { EpiResid E2{xw, (float*)(a.ws + OFF_X), (bf16_t*)(a.ws + OFF_ST), (float*)(a.ws + OFF_MG)};
                  pg8::gemm_phase<EpiResid, pg8::StaticOrder, true, true>(lds3, g, S, E2); }
#endif
                const float* xin = xw; if (l == 0 && ph == 0) xin = a.in[0];
                EpiResid E{xin, xw, xb, ss + (size_t)(2 * l + 1 + (ph >> 1)) * MT * 16};
                pg8::gemm_phase<EpiResid, pg8::StaticOrder, true, true>(lds3, g, S, E);
            } else
            {
                pg8::Gemm g{xb, (const bf16_t*)(wb + LW_WUP), MT, FF2, DM, DM, DM}; pg8::StaticOrder S; S.init(MT, FF2, G, opaque_bx());
                float* rt = (float*)(lds + 131072); int* pt = (int*)(lds + 131072 + 12288);
                fill_rstd<false, 6>(S, ss + (size_t)(2 * l + 1) * MT * 16, rt, pt, tid);
                EpiSwiGLU E{(bf16_t*)(a.ws + OFF_HID), rt, pt, 6};
                pg8::gemm_phase<EpiSwiGLU, pg8::StaticOrder, true, true>(lds3, g, S, E);
            }
            GRID_SYNC();
        }
    }
    {
        ARGS_HERE(a);
        const float* xw = a.out;
        const float* ssf = (const float*)(a.ws + OFF_SS) + (size_t)8 * MT * 16; const float* fg = a.in[17];
        int tf = tid; asm volatile("" : "+v"(tf));
        const int wave = tf >> 6, lane = tf & 63;
        f32x4 g4[4];
#pragma unroll
        for (int j = 0; j < 4; ++j) g4[j] = *(const f32x4*)(fg + 4 * lane + 256 * j);
        for (int m = blockIdx.x * 8 + wave; m < MT; m += 4 * G * 8) {
            float rs[4]; f32x4 v[4][4];
#pragma unroll
            for (int r = 0; r < 4; ++r) {
                const int mr = min(m + r * G * 8, MT - 1);
                rs[r] = row_rstd(ssf, mr);
#pragma unroll
                for (int j = 0; j < 4; ++j) v[r][j] = *(const f32x4*)(xw + (size_t)mr * DM + 4 * lane + 256 * j);
            }
#pragma unroll
            for (int r = 0; r < 4; ++r) {
                const int mr = m + r * G * 8;
                if (mr < MT) {
#pragma unroll
                    for (int j = 0; j < 4; ++j) *(f32x4*)(a.out + (size_t)mr * DM + 4 * lane + 256 * j) = v[r][j] * rs[r] * g4[j];
                }
            }
        }
    }
}

extern "C" void kernel_launch(void* const* d_in, const int* in_sizes, int n_in, void* d_out, int out_size, void* d_ws, size_t ws_size, hipStream_t stream) {
    static int grid = 0;
    if (grid == 0) {
        if (n_in != 18 || out_size != MT * DM || ws_size < WS_END) { fprintf(stderr, "kernel_launch: unexpected shapes / workspace (%d inputs, out %d, ws %zu < %zu)\n", n_in, out_size, ws_size, (size_t)WS_END); grid = -1; return; }
        int dev = 0, cus = 0, per_cu = 0;
        hipGetDevice(&dev);
        hipDeviceGetAttribute(&cus, hipDeviceAttributeMultiprocessorCount, dev);
        hipFuncSetAttribute((const void*)mega_fwd, hipFuncAttributeMaxDynamicSharedMemorySize, LDS_BYTES);
        hipOccupancyMaxActiveBlocksPerMultiprocessor(&per_cu, (const void*)mega_fwd, NTHR, LDS_BYTES);
        (void)hipGetLastError();
        if (per_cu < 1) per_cu = 1;
        grid = cus * 1;
    }
    if (grid < 0) return;
    Args a{};
    for (int i = 0; i < 18; ++i) a.in[i] = (const float*)d_in[i];
    a.out = (float*)d_out; a.ws = (unsigned char*)d_ws;
    (void)hipMemsetAsync((unsigned char*)d_ws + OFF_BAR, 0, BAR_BYTES, stream);
    void* args[] = {&a};
    hipError_t e = hipLaunchCooperativeKernel((const void*)mega_fwd, dim3(grid), dim3(NTHR), args, LDS_BYTES, stream);
    if (e != hipSuccess) fprintf(stderr, "cooperative launch failed: %s (grid %d)\n", hipGetErrorString(e), grid);
}
```

```cpp
#include <hip/hip_runtime.h>
#include <hip/hip_cooperative_groups.h>
#include <cstdio>
#include <cstdint>
namespace cg = cooperative_groups;
namespace pg8 {
#define PG8_LAS __attribute__((address_space(3)))
typedef unsigned short bf16_t;
typedef short bf16x8 __attribute__((ext_vector_type(8)));
typedef float f32x4 __attribute__((ext_vector_type(4)));
typedef unsigned u32x4 __attribute__((ext_vector_type(4)));
constexpr int BM = 256, BK = 64, HALF = 128, HTB = HALF * BK * 2  , STAGE_BYTES = 8 * HTB, NXCD = 8, WGM = 8;

__host__ __device__ __forceinline__ int lds_byte(int r, int c) { const int st = (r >> 4) * 2 + (c >> 5), rr = r & 15, cc = c & 31, ob = rr * 64 + cc * 2; return st * 1024 + (ob ^ (((ob >> 9) & 1) << 5)); }
__host__ __device__ __forceinline__ void stage_rc(int b, int& R, int& C) { const int st = b / 1024, sb = b % 1024, swz = sb ^ (((sb >> 9) & 1) << 5); R = (st >> 1) * 16 + swz / 64; C = (st & 1) * 32 + (swz % 64) / 2; }
__host__ __device__ __forceinline__ int perm32(int rho) { const int n = rho >> 4, i = rho & 15; return 8 * (i >> 2) + 4 * n + (i & 3); }

struct Unit { int pm, pn; };
struct Gemm { const bf16_t* A; const bf16_t* Bt; int M, N, K, lda, ldb; };

struct StaticOrder {
    int nM, nN, nwg, G, c, wgm = 4;
    __host__ __device__ void init(int M, int N, int G_, int c_) { nM = M / BM; nN = N / BM; nwg = nM * nN; G = G_; c = c_; }
    __host__ __device__ bool next(int i, Unit& u) const {
        const long L = (long)i * G + c; if (L >= nwg) return false;
        int wgid = (int)L; { const int q = nwg / NXCD, r = nwg % NXCD, xcd = wgid % NXCD, off = wgid / NXCD; wgid = (xcd < r ? xcd * (q + 1) : r * (q + 1) + (xcd - r) * q) + off; }
        const int nig = wgm * nN, gid = wgid / nig, fm = gid * wgm, gsz = (nM - fm) < wgm ? (nM - fm) : wgm;
        u.pm = fm + ((wgid % nig) % gsz); u.pn = (wgid % nig) / gsz; return true;
    }
    __device__ __forceinline__ size_t a_off(const Unit&) const { return 0; }
    __device__ __forceinline__ void a_ready(const Unit&) const {}
    __device__ __forceinline__ void done(const Unit&) const {}
};

template <class Epi, class Sched, bool ALIGN_EPI = false, bool SP2 = false>
__device__ __forceinline__ void gemm_phase(PG8_LAS unsigned char* lds, const Gemm g, const Sched& S, const Epi& E) {
    int tid0_ = threadIdx.x; asm volatile("" : "+v"(tid0_));
    const int tid = tid0_, wid = __builtin_amdgcn_readfirstlane(tid >> 6), lane = tid & 63, wr = wid >> 2, wc = wid & 3, fr = lane & 15, fq = lane >> 4;
    const int K = g.K, nt = K / BK;
    unsigned voffA[2], voffB[2];
#pragma unroll
    for (int i = 0; i < 2; ++i) { int R, C; stage_rc(tid * 16 + i * 8192, R, C); const int Rb = Epi::PERM ? ((R & ~31) + perm32(R & 31)) : R;
        voffA[i] = (unsigned)(R * g.lda + C) * 2u; voffB[i] = (unsigned)(Rb * g.ldb + C) * 2u; }
    const size_t kstep = (size_t)(BK * 2);
    const size_t hstepA = (size_t)HALF * g.lda * 2, hstepB = (size_t)HALF * g.ldb * 2;
    const size_t tstepA = 2 * hstepA, tstepB = 2 * hstepB;
    const unsigned ldsw = (unsigned)wid * 1024u;
    const int aoff = lds_byte(wr * 64 + fr, fq * 8), boff = lds_byte(wc * 32 + fr, fq * 8);
#define PG8_SA(b, h) (((b) * 2 + (h)) * HTB)
#define PG8_SB(b, h) ((4 + (b) * 2 + (h)) * HTB)
#define PG8_STAGE(bufoff, gbase, voff) do { _Pragma("unroll") for (int _i = 0; _i < 2; ++_i) \
        __builtin_amdgcn_global_load_lds((const unsigned*)((const char*)(gbase) + (voff)[_i]), (PG8_LAS unsigned*)(lds + (bufoff) + ldsw + _i * 8192), 16, 0, 0); } while (0)
#define PG8_LDA(dst, b, h) do { _Pragma("unroll") for (int m = 0; m < 4; ++m) _Pragma("unroll") for (int k = 0; k < 2; ++k) dst[m][k] = *(const PG8_LAS bf16x8*)(lds + PG8_SA(b, h) + aoff + m * 2048 + k * 1024); } while (0)
#define PG8_LDB(dst, b, h) do { _Pragma("unroll") for (int n = 0; n < 2; ++n) _Pragma("unroll") for (int k = 0; k < 2; ++k) dst[n][k] = *(const PG8_LAS bf16x8*)(lds + PG8_SB(b, h) + boff + n * 2048 + k * 1024); } while (0)
#define PG8_MMA(ai, bj, At, Bt) do { __builtin_amdgcn_s_setprio(1); _Pragma("unroll") for (int m = 0; m < 4; ++m) _Pragma("unroll") for (int n = 0; n < 2; ++n) _Pragma("unroll") for (int k = 0; k < 2; ++k) \
        acc[ai][bj][m][n] = __builtin_amdgcn_mfma_f32_16x16x32_bf16(Bt[n][k], At[m][k], acc[ai][bj][m][n], 0, 0, 0); __builtin_amdgcn_s_setprio(0); } while (0)
#define PG8_WAIT_V(n) asm volatile("s_waitcnt vmcnt(" #n ")" ::: "memory")
#define PG8_WAIT_L(n) asm volatile("s_waitcnt lgkmcnt(" #n ")" ::: "memory")
#define PG8_BAR __builtin_amdgcn_s_barrier()
#define PG8_SCHED __builtin_amdgcn_sched_barrier(0)
    Unit cur, nxt; int ui = 0;
    if (!S.next(0, cur)) return;
    f32x4 acc[2][2][4][2];
#pragma unroll
    for (int a = 0; a < 2; ++a)
#pragma unroll
        for (int b = 0; b < 2; ++b)
#pragma unroll
            for (int m = 0; m < 4; ++m)
#pragma unroll
                for (int n = 0; n < 2; ++n) acc[a][b][m][n] = (f32x4){0.f, 0.f, 0.f, 0.f};
    bf16x8 At[4][2], B0[2][2], B1[2][2];
    const char* cA = (const char*)g.A + (size_t)cur.pm * tstepA + S.a_off(cur); const char* cB = (const char*)g.Bt + (size_t)cur.pn * tstepB;
    S.a_ready(cur);
    if constexpr (SP2) {
        PG8_STAGE(PG8_SB(0, 0), cB, voffB); PG8_STAGE(PG8_SB(0, 1), cB + hstepB, voffB); PG8_STAGE(PG8_SA(0, 0), cA, voffA); PG8_STAGE(PG8_SA(0, 1), cA + hstepA, voffA);
        if (wr == 1) PG8_BAR;
        PG8_WAIT_V(2); PG8_BAR;
        PG8_STAGE(PG8_SB(1, 0), cB + kstep, voffB); PG8_STAGE(PG8_SA(1, 0), cA + kstep, voffA); PG8_STAGE(PG8_SB(1, 1), cB + hstepB + kstep, voffB);
        PG8_WAIT_V(6); PG8_BAR;
    } else {
        PG8_STAGE(PG8_SB(0, 0), cB, voffB); PG8_STAGE(PG8_SA(0, 0), cA, voffA); PG8_STAGE(PG8_SB(0, 1), cB + hstepB, voffB); PG8_STAGE(PG8_SA(0, 1), cA + hstepA, voffA);
        if (wr == 1) PG8_BAR;
        PG8_WAIT_V(4); PG8_BAR;
        PG8_STAGE(PG8_SB(1, 0), cB + kstep, voffB); PG8_STAGE(PG8_SA(1, 0), cA + kstep, voffA); PG8_STAGE(PG8_SB(1, 1), cB + hstepB + kstep, voffB);
        PG8_WAIT_V(6); PG8_BAR;
    }
    for (;;) {
        const bool has_next = __builtin_amdgcn_readfirstlane((int)S.next(ui + 1, nxt)) != 0;
        const char* nA = has_next ? (const char*)g.A + (size_t)nxt.pm * tstepA + S.a_off(nxt) : cA; const char* nB = has_next ? (const char*)g.Bt + (size_t)nxt.pn * tstepB : cB;
        for (int t = 0; t < nt; t += 2) {
            const bool last = (t == nt - 2);
            const char* a1 = cA + (size_t)(t + 1) * kstep;
            const char* a2 = last ? nA : cA + (size_t)(t + 2) * kstep; const char* b2 = last ? nB : cB + (size_t)(t + 2) * kstep;
            const char* a3 = a2 + kstep; const char* b3 = b2 + kstep;
            if (last && has_next) S.a_ready(nxt);
            if constexpr (SP2) {
            PG8_LDB(B0, 0, 0); PG8_LDB(B1, 0, 1); PG8_SCHED; PG8_LDA(At, 0, 0); PG8_STAGE(PG8_SA(1, 1), a1 + hstepA, voffA);
            PG8_WAIT_V(8); PG8_WAIT_L(0); PG8_BAR; PG8_MMA(0, 0, At, B0); PG8_MMA(0, 1, At, B1); PG8_BAR; PG8_SCHED;
            PG8_LDA(At, 0, 1); PG8_STAGE(PG8_SB(0, 0), b2, voffB); PG8_STAGE(PG8_SB(0, 1), b2 + hstepB, voffB); PG8_STAGE(PG8_SA(0, 0), a2, voffA);
            PG8_WAIT_V(8); PG8_WAIT_L(0); PG8_BAR; PG8_MMA(1, 0, At, B0); PG8_MMA(1, 1, At, B1); PG8_BAR; PG8_SCHED;
            PG8_LDB(B0, 1, 0); PG8_LDB(B1, 1, 1); PG8_SCHED; PG8_LDA(At, 1, 0); PG8_STAGE(PG8_SA(0, 1), a2 + hstepA, voffA);
            PG8_WAIT_V(8); PG8_WAIT_L(0); PG8_BAR; PG8_MMA(0, 0, At, B0); PG8_MMA(0, 1, At, B1); PG8_BAR; PG8_SCHED;
            PG8_LDA(At, 1, 1); PG8_STAGE(PG8_SB(1, 0), b3, voffB); PG8_STAGE(PG8_SB(1, 1), b3 + hstepB, voffB); PG8_STAGE(PG8_SA(1, 0), a3, voffA);
            PG8_WAIT_V(8); PG8_WAIT_L(0); PG8_BAR; PG8_MMA(1, 0, At, B0); PG8_MMA(1, 1, At, B1); PG8_BAR; PG8_SCHED;
            } else {
            PG8_LDB(B0, 0, 0); PG8_SCHED; PG8_LDA(At, 0, 0); PG8_STAGE(PG8_SA(1, 1), a1 + hstepA, voffA);
            PG8_WAIT_L(8); PG8_BAR; PG8_WAIT_L(0); PG8_MMA(0, 0, At, B0); PG8_BAR; PG8_SCHED;
            PG8_LDB(B1, 0, 1); PG8_STAGE(PG8_SB(0, 0), b2, voffB);
            PG8_BAR; PG8_WAIT_L(0); PG8_MMA(0, 1, At, B1); PG8_BAR;
            PG8_LDA(At, 0, 1); PG8_STAGE(PG8_SA(0, 0), a2, voffA);
            PG8_BAR; PG8_WAIT_L(0); PG8_MMA(1, 0, At, B0); PG8_BAR; PG8_SCHED;
            PG8_STAGE(PG8_SB(0, 1), b2 + hstepB, voffB);
            PG8_WAIT_V(6); PG8_BAR; PG8_MMA(1, 1, At, B1); PG8_BAR;
            PG8_LDB(B0, 1, 0); PG8_SCHED; PG8_LDA(At, 1, 0); PG8_STAGE(PG8_SA(0, 1), a2 + hstepA, voffA);
            PG8_WAIT_L(8); PG8_BAR; PG8_WAIT_L(0); PG8_MMA(0, 0, At, B0); PG8_BAR; PG8_SCHED;
            PG8_LDB(B1, 1, 1); PG8_STAGE(PG8_SB(1, 0), b3, voffB);
            PG8_BAR; PG8_WAIT_L(0); PG8_MMA(0, 1, At, B1); PG8_BAR;
            PG8_LDA(At, 1, 1); PG8_STAGE(PG8_SA(1, 0), a3, voffA);
            PG8_BAR; PG8_WAIT_L(0); PG8_MMA(1, 0, At, B0); PG8_BAR; PG8_SCHED;
            PG8_STAGE(PG8_SB(1, 1), b3 + hstepB, voffB);
            PG8_WAIT_V(6); PG8_BAR; PG8_MMA(1, 1, At, B1); PG8_BAR;
            }
        }
        if constexpr (ALIGN_EPI) { if (wr == 0) PG8_BAR; }
        if constexpr (!Epi::AFTER_DRAIN) { E(acc, cur, wr, wc, fr, fq); S.done(cur); }
        if (!has_next) break;
#pragma unroll
        for (int a = 0; a < 2; ++a)
#pragma unroll
            for (int b = 0; b < 2; ++b)
#pragma unroll
                for (int m = 0; m < 4; ++m)
#pragma unroll
                    for (int n = 0; n < 2; ++n) acc[a][b][m][n] = (f32x4){0.f, 0.f, 0.f, 0.f};
        cur = nxt; cA = nA; cB = nB; ++ui;
        if constexpr (ALIGN_EPI) { if (wr == 1) PG8_BAR; }
    }
    PG8_WAIT_V(0);
    if constexpr (!ALIGN_EPI) { if (wr == 0) PG8_BAR; }
    PG8_BAR;
    if constexpr (Epi::AFTER_DRAIN) { E.fused(acc, cur, wr, wc, fr, fq, lds, wid, lane); S.done(cur); }
#undef PG8_SA
#undef PG8_SB
#undef PG8_STAGE
#undef PG8_LDA
#undef PG8_LDB
#undef PG8_MMA
#undef PG8_WAIT_V
#undef PG8_WAIT_L
#undef PG8_BAR
#undef PG8_SCHED
}
}

#define DI __device__ __forceinline__
typedef unsigned short bf16_t;
typedef short bf16x8 __attribute__((ext_vector_type(8)));
typedef float f32x4 __attribute__((ext_vector_type(4)));
typedef unsigned u32x4 __attribute__((ext_vector_type(4)));
typedef unsigned u32x2 __attribute__((ext_vector_type(2)));

constexpr int NB = 4, SEQ = 4096, DM = 1024, MT = NB * SEQ, NL = 4;
constexpr int INW = 12304, NPJ = 9472, PJ = 9216, NVT = 3072, FF = 2816, FF2 = 5632;
constexpr float EPSF = 1e-6f;
constexpr int NTHR = 512;
constexpr int LDS_BYTES = 163840;

constexpr size_t SZ_WIN = (size_t)NPJ * DM * 2, SZ_WV = (size_t)NVT * DM * 2, SZ_WO = (size_t)DM * DM * 2, SZ_WUP = (size_t)FF2 * DM * 2, SZ_WDN = (size_t)DM * FF * 2;
constexpr size_t LW_WIN = 0, LW_WV = LW_WIN + SZ_WIN, LW_WO = LW_WV + SZ_WV, LW_WOUT = LW_WO + 3 * SZ_WO, LW_WUP = LW_WOUT + SZ_WO, LW_WDN = LW_WUP + SZ_WUP, LAYER_W = LW_WDN + SZ_WDN;
constexpr size_t OFF_WB = 0;
constexpr size_t OFF_PROJ = OFF_WB + NL * LAYER_W;
constexpr size_t OFF_VT = OFF_PROJ + (size_t)MT * PJ * 2;
constexpr size_t OFF_X = OFF_VT + (size_t)NVT * MT * 2;
constexpr size_t OFF_XB = OFF_X + (size_t)MT * DM * 4;
constexpr size_t OFF_ST = OFF_XB + (size_t)MT * DM * 2;
constexpr size_t OFF_COS = OFF_ST + (size_t)2 * 16 * 32 * 256 * 128 * 2;
constexpr size_t OFF_SIN = OFF_COS + (size_t)SEQ * 64 * 4;
constexpr size_t OFF_MG = OFF_SIN + (size_t)SEQ * 64 * 4;
constexpr size_t OFF_NS = OFF_MG + (size_t)MT * 16 * 4;
constexpr size_t OFF_CDEC = OFF_NS + (size_t)2 * 16 * 32 * 128 * 4;
constexpr size_t OFF_SS = OFF_CDEC + 8192;
constexpr size_t OFF_BAR = OFF_SS + (size_t)9 * MT * 16 * 4;
constexpr size_t BAR_BYTES = 16384;
constexpr size_t WS_END = OFF_BAR + BAR_BYTES;
constexpr size_t OFF_MF = OFF_VT, OFF_MB = OFF_VT + (size_t)MT * DM * 4;
static_assert(OFF_MB + (size_t)MT * DM * 2 <= OFF_X, "merged overlay");
constexpr size_t OFF_HID = OFF_PROJ;

struct Args { const float* in[18]; float* out; unsigned char* ws; };

typedef float f32x2_t __attribute__((ext_vector_type(2))); typedef __bf16 bf16x2_t __attribute__((ext_vector_type(2)));
DI unsigned pk2(float lo, float hi) { f32x2_t v = {lo, hi}; bf16x2_t b = __builtin_convertvector(v, bf16x2_t); return __builtin_bit_cast(unsigned, b); }
DI float bflo(unsigned w) { return __uint_as_float(w << 16); }
DI float bfhi(unsigned w) { return __uint_as_float(w & 0xffff0000u); }
DI float bf2f(bf16_t h) { return __uint_as_float((unsigned)h << 16); }
DI bf16_t f2bf(float f) { return (bf16_t)(pk2(f, 0.f) & 0xffffu); }
DI float sigm(float x) { return 1.f / (1.f + __expf(-x)); }
DI float silu(float x) { return x * sigm(x); }
DI float logsig(float x) { return fminf(x, 0.f) - log1pf(__expf(-fabsf(x))); }
DI float row_rstd(const float* ssp, int row) { const f32x4* p = (const f32x4*)(ssp + (size_t)row * 16); const f32x4 a = p[0], b = p[1], c = p[2], d = p[3];
    const float s = (((a[0] + a[1]) + (a[2] + a[3])) + ((b[0] + b[1]) + (b[2] + b[3]))) + (((c[0] + c[1]) + (c[2] + c[3])) + ((d[0] + d[1]) + (d[2] + d[3]))); return rsqrtf(s * (1.f / DM) + EPSF); }
DI int swz(int row, int col) { return row * 256 + ((((col >> 3) ^ (row & 15)) << 4) | ((col & 7) << 1)); }
DI int swzt(int row, int col) { return row * 256 + (((((col >> 3) ^ (row & 15) ^ ((row >> 4) & 7)) & 15) << 4) | ((col & 7) << 1)); }
DI f32x4 mfma16(bf16x8 a, bf16x8 b, f32x4 c) { return __builtin_amdgcn_mfma_f32_16x16x32_bf16(a, b, c, 0, 0, 0); }
DI void unpack8(u32x4 r, float (&o)[8]) { o[0] = bflo(r.x); o[1] = bfhi(r.x); o[2] = bflo(r.y); o[3] = bfhi(r.y); o[4] = bflo(r.z); o[5] = bfhi(r.z); o[6] = bflo(r.w); o[7] = bfhi(r.w); }
DI u32x4 pack8(const float (&v)[8]) { u32x4 w; w.x = pk2(v[0], v[1]); w.y = pk2(v[2], v[3]); w.z = pk2(v[4], v[5]); w.w = pk2(v[6], v[7]); return w; }

DI int find_slot(const int* pt, int nu, int tile) { int s = 0; for (int i = nu - 1; i >= 0; --i) if (pt[i] == tile) s = i; return s; }
struct EpiInProj {
    static constexpr bool PERM = true, AFTER_DRAIN = false;
    bf16_t* proj; const float* rt; const int* pt; int nu; const float* cosT; const float* sinT; const float* gate_b;
    template <int MODE>
    DI void body(const f32x4 (&acc)[2][2][4][2], const pg8::Unit& u, const float* rtu, int wr, int wc, int fr, int fq) const {
        const int pn = u.pn;
        f32x4 cs[2][4], sn[2][4], gb[2][2];
        if (MODE == 0) {
#pragma unroll
            for (int ai = 0; ai < 2; ++ai)
#pragma unroll
                for (int m = 0; m < 4; ++m) {
                    const int t = (u.pm * 256 + ai * 128 + wr * 64 + m * 16 + fr) & (SEQ - 1), i0 = wc * 16 + 4 * fq;
                    cs[ai][m] = *(const f32x4*)(cosT + t * 64 + i0); sn[ai][m] = *(const f32x4*)(sinT + t * 64 + i0);
                }
        }
        if (MODE == 5) {
#pragma unroll
            for (int bj = 0; bj < 2; ++bj) { const int c0 = pn * 256 + bj * 128 + wc * 32 + 8 * fq; gb[bj][0] = *(const f32x4*)(gate_b + c0 - 6144); gb[bj][1] = *(const f32x4*)(gate_b + c0 - 6144 + 4); }
        }
#pragma unroll
        for (int ai = 0; ai < 2; ++ai)
#pragma unroll
            for (int m = 0; m < 4; ++m) {
                const int row = u.pm * 256 + ai * 128 + wr * 64 + m * 16 + fr;
                const float rs = rtu[ai * 128 + wr * 64 + m * 16 + fr];
#pragma unroll
                for (int bj = 0; bj < 2; ++bj) {
                    const int c0 = pn * 256 + bj * 128 + wc * 32 + 8 * fq;
                    float v[8];
#pragma unroll
                    for (int k = 0; k < 4; ++k) { v[k] = acc[ai][bj][m][0][k] * rs; v[4 + k] = acc[ai][bj][m][1][k] * rs; }
                    if (MODE == 0) {
                        const float sc = bj == 0 ? 0.08838834764831845f : 1.f;
#pragma unroll
                        for (int k = 0; k < 4; ++k) { const float x1 = v[2 * k], x2 = v[2 * k + 1]; v[2 * k] = (x1 * cs[ai][m][k] - x2 * sn[ai][m][k]) * sc; v[2 * k + 1] = (x1 * sn[ai][m][k] + x2 * cs[ai][m][k]) * sc; }
                    } else if (MODE == 1) {
#pragma unroll
                        for (int k = 0; k < 8; ++k) v[k] = silu(v[k]);
                    } else if (MODE == 2) {
#pragma unroll
                        for (int k = 0; k < 8; ++k) v[k] *= 0.125f;
                    } else if (MODE == 4) {
#pragma unroll
                        for (int k = 0; k < 8; ++k) v[k] = sigm(v[k]);
                    } else if (MODE == 5) {
#pragma unroll
                        for (int k = 0; k < 4; ++k) { v[k] = sigm(v[k] + gb[bj][0][k]); v[4 + k] = sigm(v[4 + k] + gb[bj][1][k]); }
                    }
                    *(u32x4*)(proj + (size_t)row * PJ + c0) = pack8(v);
                }
            }
    }
    DI void operator()(const f32x4 (&acc)[2][2][4][2], const pg8::Unit& u, int wr, int wc, int fr, int fq) const {
        asm volatile("" : "+v"(fr), "+v"(fq));
        const int pn = u.pn;
        const float* rtu = rt + find_slot(pt, nu, u.pm) * 256;
        if (pn < 4) body<0>(acc, u, rtu, wr, wc, fr, fq);
        else if (pn < 8) body<1>(acc, u, rtu, wr, wc, fr, fq);
        else if (pn < 12) body<2>(acc, u, rtu, wr, wc, fr, fq);
        else if (pn < 20) body<3>(acc, u, rtu, wr, wc, fr, fq);
        else if (pn < 24) body<4>(acc, u, rtu, wr, wc, fr, fq);
        else body<5>(acc, u, rtu, wr, wc, fr, fq);
    }
};
struct EpiVt {
    static constexpr bool PERM = true, AFTER_DRAIN = false;
    bf16_t* vt; const float* rt; const int* pt;
    DI void operator()(const f32x4 (&acc)[2][2][4][2], const pg8::Unit& u, int wr, int wc, int fr, int fq) const {
        asm volatile("" : "+v"(fr), "+v"(fq));
#pragma unroll
        for (int bj = 0; bj < 2; ++bj) {
            const int c0 = u.pn * 256 + bj * 128 + wc * 32 + 8 * fq;
            const int slot = find_slot(pt, 3, u.pn);
            const float* rp = rt + slot * 256 + bj * 128 + wc * 32 + 8 * fq;
            const f32x4 s0 = *(const f32x4*)rp, s1 = *(const f32x4*)(rp + 4);
            float rs[8];
#pragma unroll
            for (int k = 0; k < 4; ++k) { rs[k] = s0[k]; rs[4 + k] = s1[k]; }
#pragma unroll
            for (int ai = 0; ai < 2; ++ai)
#pragma unroll
                for (int m = 0; m < 4; ++m) {
                    const int row = u.pm * 256 + ai * 128 + wr * 64 + m * 16 + fr;
                    float v[8];
#pragma unroll
                    for (int k = 0; k < 4; ++k) { v[k] = acc[ai][bj][m][0][k] * rs[k]; v[4 + k] = acc[ai][bj][m][1][k] * rs[4 + k]; }
                    *(u32x4*)(vt + (size_t)row * MT + c0) = pack8(v);
                }
        }
    }
};
struct OutProjOrder {
    pg8::StaticOrder S0;
    DI bool next(int i, pg8::Unit& u) const { if (i >= 3) return false; pg8::Unit b; if (!S0.next(0, b)) return false; u.pm = b.pm; u.pn = i * 4 + b.pn; return true; }
    DI size_t a_off(const pg8::Unit& u) const { const int br = u.pn >> 2; return (size_t)(br == 0 ? 1024 : (br == 1 ? 2048 : 5120)) * 2; }
    DI void a_ready(const pg8::Unit&) const {}
    DI void done(const pg8::Unit&) const {}
};
struct EpiOutProj {
    static constexpr bool PERM = true, AFTER_DRAIN = false;
    const bf16_t* proj; bf16_t* mb;
    DI void operator()(const f32x4 (&acc)[2][2][4][2], const pg8::Unit& u, int wr, int wc, int fr, int fq) const {
        asm volatile("" : "+v"(fr), "+v"(fq));
        const int br = u.pn >> 2, pn = u.pn & 3;
        const bf16_t* gates = proj + 6144 + br * 1024;
#pragma unroll
        for (int ai = 0; ai < 2; ++ai) {
            u32x4 gv[4][2], pv[4][2];
#pragma unroll
            for (int m = 0; m < 4; ++m)
#pragma unroll
                for (int bj = 0; bj < 2; ++bj) {
                    const int row = u.pm * 256 + ai * 128 + wr * 64 + m * 16 + fr, c0 = pn * 256 + bj * 128 + wc * 32 + 8 * fq;
                    gv[m][bj] = *(const u32x4*)(gates + (size_t)row * PJ + c0);
                    pv[m][bj] = br != 0 ? *(const u32x4*)(mb + (size_t)row * DM + c0) : (u32x4){0u, 0u, 0u, 0u};
                }
#pragma unroll
            for (int m = 0; m < 4; ++m)
#pragma unroll
                for (int bj = 0; bj < 2; ++bj) {
                    const int row = u.pm * 256 + ai * 128 + wr * 64 + m * 16 + fr, c0 = pn * 256 + bj * 128 + wc * 32 + 8 * fq;
                    float g[8], p[8], v[8];
                    unpack8(gv[m][bj], g); unpack8(pv[m][bj], p);
#pragma unroll
                    for (int k = 0; k < 4; ++k) { v[k] = acc[ai][bj][m][0][k] * g[k] + p[k]; v[4 + k] = acc[ai][bj][m][1][k] * g[4 + k] + p[4 + k]; }
                    *(u32x4*)(mb + (size_t)row * DM + c0) = pack8(v);
                }
        }
    }
};
struct EpiResid {
    static constexpr bool PERM = true, AFTER_DRAIN = false;
    const float* xi; float* x; bf16_t* xb; float* ssn;
    DI void operator()(const f32x4 (&acc)[2][2][4][2], const pg8::Unit& u, int wr, int wc, int fr, int fq) const {
        asm volatile("" : "+v"(fr), "+v"(fq));
#pragma unroll
        for (int ai = 0; ai < 2; ++ai)
#pragma unroll
            for (int m = 0; m < 4; ++m) {
                const int row = u.pm * 256 + ai * 128 + wr * 64 + m * 16 + fr;
                float sq = 0.f;
#pragma unroll
                for (int bj = 0; bj < 2; ++bj) {
                    const int c0 = u.pn * 256 + bj * 128 + wc * 32 + 8 * fq;
                    float* xp = x + (size_t)row * DM + c0; const float* xip = xi + (size_t)row * DM + c0;
                    const f32x4 a0 = *(const f32x4*)xip, a1 = *(const f32x4*)(xip + 4);
                    float v[8];
#pragma unroll
                    for (int k = 0; k < 4; ++k) { v[k] = acc[ai][bj][m][0][k] + a0[k]; v[4 + k] = acc[ai][bj][m][1][k] + a1[k]; }
#pragma unroll
                    for (int k = 0; k < 8; ++k) sq += v[k] * v[k];
                    *(f32x4*)xp = (f32x4){v[0], v[1], v[2], v[3]}; *(f32x4*)(xp + 4) = (f32x4){v[4], v[5], v[6], v[7]};
                    *(u32x4*)(xb + (size_t)row * DM + c0) = pack8(v);
                }
                sq += __shfl_xor(sq, 16); sq += __shfl_xor(sq, 32);
                if (fq == 0) ssn[(size_t)row * 16 + u.pn * 4 + wc] = sq;
            }
    }
};
struct EpiSwiGLU {
    static constexpr bool PERM = true, AFTER_DRAIN = false;
    bf16_t* hid; const float* rt; const int* pt; int nu;
    DI void operator()(const f32x4 (&acc)[2][2][4][2], const pg8::Unit& u, int wr, int wc, int fr, int fq) const {
        asm volatile("" : "+v"(fr), "+v"(fq));
        const float* rtu = rt + find_slot(pt, nu, u.pm) * 256;
#pragma unroll
        for (int ai = 0; ai < 2; ++ai)
#pragma unroll
            for (int m = 0; m < 4; ++m) {
                const int row = u.pm * 256 + ai * 128 + wr * 64 + m * 16 + fr;
                const float rs = rtu[ai * 128 + wr * 64 + m * 16 + fr];
#pragma unroll
                for (int bj = 0; bj < 2; ++bj) {
                    const int c0 = u.pn * 256 + bj * 128 + wc * 32 + 8 * fq;
                    float v[8];
#pragma unroll
                    for (int k = 0; k < 4; ++k) { v[k] = acc[ai][bj][m][0][k] * rs; v[4 + k] = acc[ai][bj][m][1][k] * rs; }
                    u32x2 w; w.x = pk2(silu(v[0]) * v[1], silu(v[2]) * v[3]); w.y = pk2(silu(v[4]) * v[5], silu(v[6]) * v[7]);
                    *(u32x2*)(hid + (size_t)row * FF + (c0 >> 1)) = w;
                }
            }
    }
};

DI int src_col(int kind, int n) {
    if (kind == 0) {
        if (n < 1024) { const int h = n >> 8, sec = (n >> 7) & 1, p = n & 127, d = (p >> 1) + 64 * (p & 1); return sec * 512 + h * 128 + d; }
        if (n < 2048) return 2048 + (n - 1024);
        if (n < 3072) return 3072 + (n - 2048);
        if (n < 4096) return 4096 + (n - 3072);
        if (n < 5120) return 6144 + (n - 4096);
        if (n < 6144) return 8192 + (n - 5120);
        if (n < 9216) return 9232 + (n - 6144);
        if (n < 9232) return n;
        return -1;
    }
    if (kind == 1) { if (n < 1024) return 1024 + n; if (n < 2048) return 5120 + (n - 1024); return 7168 + (n - 2048); }
    if (kind == 3) return (n >> 1) + FF * (n & 1);
    return n;
}
DI void src_cols8(int kind, int n, int& ca, int& cb, bool& il) {
    if (kind == 0 && n < 1024) { const int h = n >> 8, sec = (n >> 7) & 1, p = n & 127; ca = sec * 512 + h * 128 + (p >> 1); cb = ca + 64; il = true; return; }
    if (kind == 3) { ca = n >> 1; cb = ca + FF; il = true; return; }
    ca = src_col(kind, n); cb = ca + 4; il = false;
}
struct WTile { const float* W; const float* gain; bf16_t* dst; int ldw, K, kind, k0, n0; };
constexpr int T_WIN = 16 * (NPJ / 64), T_WV = 16 * (NVT / 64), T_WO = 16 * 16, T_WUP = 16 * (FF2 / 64), T_WDN = (FF / 64) * 16;
constexpr int T_LAYER = T_WIN + T_WV + 4 * T_WO + T_WUP + T_WDN;
DI WTile wtile_of(const Args& a, int g) {
    WTile t; const int l = g / T_LAYER; int r = g % T_LAYER;
    unsigned char* wb = a.ws + OFF_WB + (size_t)l * LAYER_W;
    int ntn;
    if (r < T_WIN) { t.W = a.in[2] + (size_t)l * DM * INW; t.ldw = INW; t.gain = a.in[1] + l * DM; t.dst = (bf16_t*)(wb + LW_WIN); t.K = DM; t.kind = 0; ntn = NPJ / 64; }
    else if ((r -= T_WIN) < T_WV) { t.W = a.in[2] + (size_t)l * DM * INW; t.ldw = INW; t.gain = a.in[1] + l * DM; t.dst = (bf16_t*)(wb + LW_WV); t.K = DM; t.kind = 1; ntn = NVT / 64; }
    else if ((r -= T_WV) < 3 * T_WO) { const int br = r / T_WO; r %= T_WO; t.W = (br == 0 ? a.in[10] : (br == 1 ? a.in[11] : a.in[12])) + (size_t)l * DM * DM; t.ldw = DM; t.gain = nullptr; t.dst = (bf16_t*)(wb + LW_WO + br * SZ_WO); t.K = DM; t.kind = 2; ntn = 16; }
    else if ((r -= 3 * T_WO) < T_WO) { t.W = a.in[13] + (size_t)l * DM * DM; t.ldw = DM; t.gain = nullptr; t.dst = (bf16_t*)(wb + LW_WOUT); t.K = DM; t.kind = 2; ntn = 16; }
    else if ((r -= T_WO) < T_WUP) { t.W = a.in[15] + (size_t)l * DM * FF2; t.ldw = FF2; t.gain = a.in[14] + l * DM; t.dst = (bf16_t*)(wb + LW_WUP); t.K = DM; t.kind = 3; ntn = FF2 / 64; }
    else { r -= T_WUP; t.W = a.in[16] + (size_t)l * FF * DM; t.ldw = DM; t.gain = nullptr; t.dst = (bf16_t*)(wb + LW_WDN); t.K = FF; t.kind = 2; ntn = 16; }
    t.k0 = (r / ntn) * 64; t.n0 = (r % ntn) * 64;
    return t;
}
DI void prologue(const Args& a, unsigned char* lds, int tid) {
    float* scr = (float*)lds;
    const int G = gridDim.x;
    constexpr int TB = 8;
    const int kk = tid >> 3, nn = (tid & 7) * 8;
    for (int g0 = blockIdx.x; g0 < NL * T_LAYER; g0 += G * TB) {
        f32x4 va[TB], vb[TB]; bool il[TB];
#pragma unroll
        for (int t = 0; t < TB; ++t) {
            const int g = g0 + t * G;
            va[t] = (f32x4){0.f, 0.f, 0.f, 0.f}; vb[t] = va[t]; il[t] = false;
            if (g < NL * T_LAYER) {
                const WTile w = wtile_of(a, g);
                const float gn = w.gain ? w.gain[w.k0 + kk] : 1.f;
                const float* wrow = w.W + (size_t)(w.k0 + kk) * w.ldw;
                int ca, cb; src_cols8(w.kind, w.n0 + nn, ca, cb, il[t]);
                if (ca >= 0) { va[t] = *(const f32x4*)(wrow + ca) * gn; vb[t] = *(const f32x4*)(wrow + cb) * gn; }
            }
        }
#pragma unroll
        for (int t = 0; t < TB; ++t) {
            float* sp = scr + t * (64 * 65) + kk * 65 + nn;
            if (il[t]) { sp[0] = va[t][0]; sp[1] = vb[t][0]; sp[2] = va[t][1]; sp[3] = vb[t][1]; sp[4] = va[t][2]; sp[5] = vb[t][2]; sp[6] = va[t][3]; sp[7] = vb[t][3]; }
            else { sp[0] = va[t][0]; sp[1] = va[t][1]; sp[2] = va[t][2]; sp[3] = va[t][3]; sp[4] = vb[t][0]; sp[5] = vb[t][1]; sp[6] = vb[t][2]; sp[7] = vb[t][3]; }
        }
        __syncthreads();
#pragma unroll
        for (int t = 0; t < TB; ++t) {
            const int g = g0 + t * G;
            if (g < NL * T_LAYER) {
                const WTile w = wtile_of(a, g);
                const int n = tid >> 3, k8 = (tid & 7) * 8;
                const float* sq = scr + t * (64 * 65);
                u32x4 o;
                o.x = pk2(sq[(k8 + 0) * 65 + n], sq[(k8 + 1) * 65 + n]); o.y = pk2(sq[(k8 + 2) * 65 + n], sq[(k8 + 3) * 65 + n]);
                o.z = pk2(sq[(k8 + 4) * 65 + n], sq[(k8 + 5) * 65 + n]); o.w = pk2(sq[(k8 + 6) * 65 + n], sq[(k8 + 7) * 65 + n]);
                *(u32x4*)(w.dst + (size_t)(w.n0 + n) * w.K + w.k0 + k8) = o;
            }
        }
        __syncthreads();
    }
    const int wave = tid >> 6, lane = tid & 63;
    bf16_t* xb = (bf16_t*)(a.ws + OFF_XB); float* ss = (float*)(a.ws + OFF_SS);
    for (int m = blockIdx.x * 8 + wave; m < MT; m += G * 8) {
        const f32x4* xr = (const f32x4*)(a.in[0] + (size_t)m * DM) + lane;
        float s = 0.f;
        f32x4 vx[4];
#pragma unroll
        for (int j = 0; j < 4; ++j) vx[j] = xr[64 * j];
#pragma unroll
        for (int j = 0; j < 4; ++j) {
            const f32x4 v = vx[j];
            s += (v[0] * v[0] + v[1] * v[1]) + (v[2] * v[2] + v[3] * v[3]);
            u32x2 w; w.x = pk2(v[0], v[1]); w.y = pk2(v[2], v[3]);
            ((u32x2*)(xb + (size_t)m * DM))[lane + 64 * j] = w;
        }
#pragma unroll
        for (int o = 1; o < 64; o <<= 1) s += __shfl_xor(s, o);
        if (lane < 16) ss[(size_t)m * 16 + lane] = lane == 0 ? s : 0.f;
    }
    const int gt = blockIdx.x * NTHR + tid, NT = G * NTHR;
    float* cosT = (float*)(a.ws + OFF_COS); float* sinT = (float*)(a.ws + OFF_SIN);
    for (int i = gt; i < SEQ * 64; i += NT) {
        const int t = i >> 6, f = i & 63;
        const float inv = exp2f(-(float)f * (13.287712379549449f / 64.f));
        const float ang = (float)t * inv;
        double rev = (double)ang * 0.15915494309189535; rev -= rint(rev);
        cosT[i] = __builtin_amdgcn_cosf((float)rev); sinT[i] = __builtin_amdgcn_sinf((float)rev);
    }
}

DI void ml_conv8(const bf16_t* proj, const float* cw, const float* cb, int tokb, int t, int ch, float (&o)[8]) {
    { const f32x4 b0 = *(const f32x4*)(cb + ch), b1 = *(const f32x4*)(cb + ch + 4);
#pragma unroll
      for (int k = 0; k < 4; ++k) { o[k] = b0[k]; o[4 + k] = b1[k]; } }
#pragma unroll
    for (int w = 0; w < 5; ++w) {
        const int tt = t + w - 2;
        if (tt >= 0 && tt < SEQ) {
            float x[8]; unpack8(*(const u32x4*)(proj + (size_t)(tokb + tt) * PJ + 4096 + ch), x);
            const f32x4 w0 = *(const f32x4*)(cw + w * 1024 + ch), w1 = *(const f32x4*)(cw + w * 1024 + ch + 4);
#pragma unroll
            for (int k = 0; k < 4; ++k) { o[k] += x[k] * w0[k]; o[4 + k] += x[4 + k] * w1[k]; }
        }
    }
#pragma unroll
    for (int k = 0; k < 8; ++k) o[k] = silu(o[k]);
}

DI void ml_conv4(const bf16_t* proj, const float* cw, const float* cb, int tokb, int t0, int ch, float (&o)[4][8]) {
    float x[8][8];
#pragma unroll
    for (int r = 0; r < 8; ++r) {
        const int tt = t0 + r - 2;
        if (tt >= 0 && tt < SEQ) unpack8(*(const u32x4*)(proj + (size_t)(tokb + tt) * PJ + 4096 + ch), x[r]);
        else {
#pragma unroll
            for (int k = 0; k < 8; ++k) x[r][k] = 0.f;
        }
    }
    { const f32x4 b0 = *(const f32x4*)(cb + ch), b1 = *(const f32x4*)(cb + ch + 4);
#pragma unroll
      for (int i = 0; i < 4; ++i)
#pragma unroll
          for (int k = 0; k < 4; ++k) { o[i][k] = b0[k]; o[i][4 + k] = b1[k]; } }
#pragma unroll
    for (int w = 0; w < 5; ++w) {
        const f32x4 w0 = *(const f32x4*)(cw + w * 1024 + ch), w1 = *(const f32x4*)(cw + w * 1024 + ch + 4);
#pragma unroll
        for (int i = 0; i < 4; ++i)
#pragma unroll
            for (int k = 0; k < 4; ++k) { o[i][k] += x[i + w][k] * w0[k]; o[i][4 + k] += x[i + w][4 + k] * w1[k]; }
    }
#pragma unroll
    for (int i = 0; i < 4; ++i)
#pragma unroll
        for (int k = 0; k < 8; ++k) o[i][k] = silu(o[i][k]);
}

DI void chunk_gates(const Args& a, int l, int mx, int h, int tok0, float* sc, int tid) {
    const int lane = tid & 63, wave = tid >> 6;
    float v = 0.f;
    if (tid < 256) {
        const int dir = tid >> 7, i = tid & 127;
        if (mx == 0) { v = logsig(a.in[4][l * 8 + dir * 4 + h]); sc[512 + tid] = 0.f; }
        else { const float* mg = (const float*)(a.ws + OFF_MG) + (size_t)(tok0 + i) * 16 + dir * 8; v = logsig(mg[4 + h]); sc[512 + tid] = mg[h]; }
    }
    const bool suffix = wave >= 2;
#pragma unroll
    for (int o = 1; o < 64; o <<= 1) {
        const float up = __shfl_up(v, o), dn = __shfl_down(v, o);
        if (suffix) { if (lane + o < 64) v += dn; } else { if (lane >= o) v += up; }
    }
    if (wave < 4 && lane == (suffix ? 0 : 63)) sc[wave] = v;
    __syncthreads();
    if (wave == 1) v += sc[0];
    if (wave == 2) v += sc[3];
    if (tid < 256) sc[256 + tid] = v;
    __syncthreads();
}

DI void mgate_tile(const Args& a, int l, int tile, int lane) {
    asm volatile("" : "+v"(lane));
    const int fr = lane & 15, fq = lane >> 4, tok0 = tile * 16;
    const bf16_t* wg = (const bf16_t*)(a.ws + OFF_WB + (size_t)l * LAYER_W + LW_WIN) + (size_t)(9216 + fr) * DM + fq * 8;
    const bf16_t* xp = (const bf16_t*)(a.ws + OFF_XB) + (size_t)(tok0 + fr) * DM + fq * 8;
    f32x4 acc0 = (f32x4){0.f, 0.f, 0.f, 0.f}, acc1 = acc0;
#pragma unroll
    for (int kb = 0; kb < 4; ++kb) {
        bf16x8 wf[8], xf[8];
#pragma unroll
        for (int k = 0; k < 8; ++k) { wf[k] = *(const bf16x8*)(wg + (kb * 8 + k) * 32); xf[k] = *(const bf16x8*)(xp + (kb * 8 + k) * 32); }
        __builtin_amdgcn_sched_barrier(0);
#pragma unroll
        for (int k = 0; k < 8; k += 2) { acc0 = mfma16(wf[k], xf[k], acc0); acc1 = mfma16(wf[k + 1], xf[k + 1], acc1); }
        __builtin_amdgcn_sched_barrier(0);
    }
    const float rs = row_rstd((const float*)(a.ws + OFF_SS) + (size_t)(2 * l) * MT * 16, tok0 + fr);
    const f32x4 bias = *(const f32x4*)(a.in[8] + l * 16 + fq * 4);
    *(f32x4*)((float*)(a.ws + OFF_MG) + (size_t)(tok0 + fr) * 16 + fq * 4) = (acc0 + acc1) * rs + bias;
}

DI void s1_unit(const Args& a, int l, int mx, int b, int h, int c, unsigned char* lds, int tid) {
    asm volatile("" : "+v"(tid));
    const int wave = tid >> 6, lane = tid & 63, fr = lane & 15, fq = lane >> 4, bh = b * 4 + h;
    const bf16_t* proj = (const bf16_t*)(a.ws + OFF_PROJ); const bf16_t* vt = (const bf16_t*)(a.ws + OFF_VT);
    bf16_t* ST = (bf16_t*)(a.ws + (mx == 0 ? OFF_ST : OFF_X)); float* NS = (float*)(a.ws + OFF_NS); float* cdec = (float*)(a.ws + OFF_CDEC) + mx * 1024;
    float* sc = (float*)(lds + 65536);
    const int tok0 = b * SEQ + c * 128;
    const int vrow = (mx == 0 ? 0 : 2048) + h * 256 + wave * 32;
    bf16x8 vf[4][2];
#pragma unroll
    for (int ks = 0; ks < 4; ++ks)
#pragma unroll
        for (int mt = 0; mt < 2; ++mt) vf[ks][mt] = *(const bf16x8*)(vt + (size_t)(vrow + mt * 16 + fr) * MT + tok0 + ks * 32 + fq * 8);
    chunk_gates(a, l, mx, h, tok0, sc, tid);
    if (tid < 256) {
        const int dir = tid >> 7, j = tid & 127;
        const float tot = dir == 0 ? sc[256 + 127] : sc[256 + 128];
        sc[768 + tid] = __expf(tot - sc[256 + tid] + sc[512 + tid]);
        if (j == 0) cdec[(dir * 16 + bh) * 32 + c] = __expf(tot);
    }
    __syncthreads();
    {
        const int g = tid & 15, j0 = (tid >> 4) * 4;
        float k4[4][8];
        if (mx == 0) {
#pragma unroll
            for (int i = 0; i < 4; ++i) unpack8(*(const u32x4*)(proj + (size_t)(tok0 + j0 + i) * PJ + h * 256 + 128 + g * 8), k4[i]);
        } else ml_conv4(proj, a.in[6] + l * 5 * 1024, a.in[7] + l * 1024, b * SEQ, c * 128 + j0, 512 + h * 128 + g * 8, k4);
        const f32x4 wf = *(const f32x4*)(sc + 768 + j0), wb = *(const f32x4*)(sc + 768 + 128 + j0);
#pragma unroll
        for (int dd = 0; dd < 8; ++dd) {
            u32x2 pf, pb;
            pf.x = pk2(k4[0][dd] * wf[0], k4[1][dd] * wf[1]); pf.y = pk2(k4[2][dd] * wf[2], k4[3][dd] * wf[3]);
            pb.x = pk2(k4[0][dd] * wb[0], k4[1][dd] * wb[1]); pb.y = pk2(k4[2][dd] * wb[2], k4[3][dd] * wb[3]);
            *(u32x2*)(lds + swzt(g * 8 + dd, j0)) = pf;
            *(u32x2*)(lds + 32768 + swzt(g * 8 + dd, j0)) = pb;
        }
    }
    __syncthreads();
#pragma unroll 1
    for (int dir = 0; dir < 2; ++dir) {
        f32x4 acc[2][8];
#pragma unroll
        for (int mt = 0; mt < 2; ++mt)
#pragma unroll
            for (int nt = 0; nt < 8; ++nt) acc[mt][nt] = (f32x4){0.f, 0.f, 0.f, 0.f};
        {
            bf16x8 kf[2][8];
#pragma unroll
            for (int nt = 0; nt < 8; ++nt) kf[0][nt] = *(const bf16x8*)(lds + dir * 32768 + swzt(nt * 16 + fr, fq * 8));
#pragma unroll
            for (int ks = 0; ks < 4; ++ks) {
                if (ks + 1 < 4) {
#pragma unroll
                    for (int nt = 0; nt < 8; ++nt) kf[(ks + 1) & 1][nt] = *(const bf16x8*)(lds + dir * 32768 + swzt(nt * 16 + fr, (ks + 1) * 32 + fq * 8));
                }
                __builtin_amdgcn_sched_barrier(0);
#pragma unroll
                for (int nt = 0; nt < 8; ++nt)
#pragma unroll
                    for (int mt = 0; mt < 2; ++mt) acc[mt][nt] = mfma16(kf[ks & 1][nt], vf[ks][mt], acc[mt][nt]);
                __builtin_amdgcn_sched_barrier(0);
            }
        }
        bf16_t* sp = ST + ((size_t)((dir * 16 + bh) * 32 + c) * 256 + wave * 32) * 128;
#pragma unroll
        for (int mt = 0; mt < 2; ++mt)
#pragma unroll
            for (int nt = 0; nt < 8; ++nt) {
                u32x2 w; w.x = pk2(acc[mt][nt][0], acc[mt][nt][1]); w.y = pk2(acc[mt][nt][2], acc[mt][nt][3]);
                *(u32x2*)(sp + (mt * 16 + fr) * 128 + nt * 16 + fq * 4) = w;
            }
    }
    if (mx == 1 && tid < 256) {
        const int dir = tid >> 7, d = tid & 127;
        float s = 0.f;
#pragma unroll
        for (int j8 = 0; j8 < 16; ++j8) {
            float k8[8]; unpack8(*(const u32x4*)(lds + dir * 32768 + swzt(d, j8 * 8)), k8);
            s += ((k8[0] + k8[1]) + (k8[2] + k8[3])) + ((k8[4] + k8[5]) + (k8[6] + k8[7]));
        }
        NS[((dir * 16 + bh) * 32 + c) * 128 + d] = s;
    }
    __syncthreads();
}

DI void s2_scan(const Args& a, int mx) {
    int tx_ = threadIdx.x; asm volatile("" : "+v"(tx_));
    const int gt = blockIdx.x * NTHR + tx_, NT = gridDim.x * NTHR;
    bf16_t* ST = (bf16_t*)(a.ws + (mx == 0 ? OFF_ST : OFF_X)); float* NS = (float*)(a.ws + OFF_NS); const float* cdec = (const float*)(a.ws + OFF_CDEC) + mx * 1024;
    for (int it = gt; it < 2 * 16 * 8192; it += NT) {
        const int dir = it >> 17, bh = (it >> 13) & 15, p4 = it & 8191;
        bf16_t* base = ST + (size_t)((dir * 16 + bh) * 32) * 32768 + p4 * 4;
        const float* dc = cdec + (dir * 16 + bh) * 32;
        u32x2 v[32]; float dcv[32];
#pragma unroll
        for (int c = 0; c < 32; ++c) { v[c] = *(const u32x2*)(base + (size_t)c * 32768); dcv[c] = dc[c]; }
        float r0 = 0.f, r1 = 0.f, r2 = 0.f, r3 = 0.f;
        if (dir == 0) {
#pragma unroll
            for (int c = 0; c < 32; ++c) {
                u32x2 o; o.x = pk2(r0, r1); o.y = pk2(r2, r3); *(u32x2*)(base + (size_t)c * 32768) = o;
                const float d = dcv[c];
                r0 = d * r0 + bflo(v[c].x); r1 = d * r1 + bfhi(v[c].x); r2 = d * r2 + bflo(v[c].y); r3 = d * r3 + bfhi(v[c].y);
            }
        } else {
#pragma unroll
            for (int c = 31; c >= 0; --c) {
                u32x2 o; o.x = pk2(r0, r1); o.y = pk2(r2, r3); *(u32x2*)(base + (size_t)c * 32768) = o;
                const float d = dcv[c];
                r0 = d * r0 + bflo(v[c].x); r1 = d * r1 + bfhi(v[c].x); r2 = d * r2 + bflo(v[c].y); r3 = d * r3 + bfhi(v[c].y);
            }
        }
    }
    if (mx == 1) {
        for (int it = gt; it < 2 * 16 * 128; it += NT) {
            const int dir = it >> 11, bh = (it >> 7) & 15, d = it & 127;
            float* base = NS + (size_t)((dir * 16 + bh) * 32) * 128 + d;
            const float* dc = cdec + (dir * 16 + bh) * 32;
            float r = 0.f, v[32], dcv[32];
#pragma unroll
            for (int c = 0; c < 32; ++c) { v[c] = base[c * 128]; dcv[c] = dc[c]; }
            if (dir == 0) {
#pragma unroll
                for (int c = 0; c < 32; ++c) { base[c * 128] = r; r = dcv[c] * r + v[c]; }
            } else {
#pragma unroll
                for (int c = 31; c >= 0; --c) { base[c * 128] = r; r = dcv[c] * r + v[c]; }
            }
        }
    }
}

DI void s3_unit(const Args& a, int l, int mx, int b, int h, int c, unsigned char* lds, int tid) {
    asm volatile("" : "+v"(tid));
    const int wave = tid >> 6, lane = tid & 63, fr = lane & 15, fq = lane >> 4, bh = b * 4 + h;
    bf16_t* proj = (bf16_t*)(a.ws + OFF_PROJ); const bf16_t* vt = (const bf16_t*)(a.ws + OFF_VT);
    const bf16_t* ST = (const bf16_t*)(a.ws + (mx == 0 ? OFF_ST : OFF_X)); const float* NS = (const float*)(a.ws + OFF_NS);
    float* sc = (float*)(lds + 131072);
    const int tok0 = b * SEQ + c * 128;
    if (mx == 0) {
        u32x4 qw[4], kw[4];
#pragma unroll
        for (int k = 0; k < 4; ++k) { const bf16_t* p = proj + (size_t)(tok0 + (tid >> 4) + 32 * k) * PJ + h * 256 + (tid & 15) * 8; qw[k] = *(const u32x4*)p; kw[k] = *(const u32x4*)(p + 128); }
#pragma unroll
        for (int k = 0; k < 4; ++k) { *(u32x4*)(lds + swz((tid >> 4) + 32 * k, (tid & 15) * 8)) = qw[k]; *(u32x4*)(lds + 32768 + swz((tid >> 4) + 32 * k, (tid & 15) * 8)) = kw[k]; }
    } else {
        const int g = tid & 15, j0 = (tid >> 4) * 4;
        float v4[4][8];
        ml_conv4(proj, a.in[6] + l * 5 * 1024, a.in[7] + l * 1024, b * SEQ, c * 128 + j0, h * 128 + g * 8, v4);
#pragma unroll
        for (int i = 0; i < 4; ++i) {
#pragma unroll
            for (int k = 0; k < 8; ++k) v4[i][k] *= 0.08838834764831845f;
            *(u32x4*)(lds + swz(j0 + i, g * 8)) = pack8(v4[i]);
        }
        ml_conv4(proj, a.in[6] + l * 5 * 1024, a.in[7] + l * 1024, b * SEQ, c * 128 + j0, 512 + h * 128 + g * 8, v4);
#pragma unroll
        for (int i = 0; i < 4; ++i) *(u32x4*)(lds + 32768 + swz(j0 + i, g * 8)) = pack8(v4[i]);
    }
    const int vrow = (mx == 0 ? 0 : 2048) + h * 256 + wave * 32;
    bf16x8 rfr[2][4][2], vfr[4][2];
    {
        const bf16_t* Vb = vt + (size_t)vrow * MT + tok0;
#pragma unroll
        for (int ks = 0; ks < 4; ++ks) { vfr[ks][0] = *(const bf16x8*)(Vb + (size_t)(fr) * MT + ks * 32 + fq * 8); vfr[ks][1] = *(const bf16x8*)(Vb + (size_t)(16 + fr) * MT + ks * 32 + fq * 8); }
    }
    if (mx == 1 && tid < 256) sc[3328 + tid] = NS[(size_t)(((tid >> 7) * 16 + bh) * 32 + c) * 128 + (tid & 127)];
    chunk_gates(a, l, mx, h, tok0, sc, tid);
    if (mx == 1 && tid < 256) {
        const int dir = tid >> 7, i = tid & 127;
        const float* np = sc + 3328 + dir * 128;
        float s = 0.f;
#pragma unroll 8
        for (int d8 = 0; d8 < 16; ++d8) {
            float q8[8]; unpack8(*(const u32x4*)(lds + swz(i, d8 * 8)), q8);
            const f32x4 n0 = *(const f32x4*)(np + d8 * 8), n1 = *(const f32x4*)(np + d8 * 8 + 4);
#pragma unroll
            for (int k = 0; k < 4; ++k) s += q8[k] * n0[k] + q8[4 + k] * n1[k];
        }
        sc[768 + tid] = s;
    }
    f32x4 sacc[8];
#pragma unroll
    for (int nt = 0; nt < 8; ++nt) sacc[nt] = (f32x4){0.f, 0.f, 0.f, 0.f};
    {
        bf16x8 kf[2][8], qf[2];
        qf[0] = *(const bf16x8*)(lds + swz(wave * 16 + fr, fq * 8));
#pragma unroll
        for (int nt = 0; nt < 8; ++nt) kf[0][nt] = *(const bf16x8*)(lds + 32768 + swz(nt * 16 + fr, fq * 8));
#pragma unroll
        for (int ks = 0; ks < 4; ++ks) {
            if (ks + 1 < 4) {
                qf[(ks + 1) & 1] = *(const bf16x8*)(lds + swz(wave * 16 + fr, (ks + 1) * 32 + fq * 8));
#pragma unroll
                for (int nt = 0; nt < 8; ++nt) kf[(ks + 1) & 1][nt] = *(const bf16x8*)(lds + 32768 + swz(nt * 16 + fr, (ks + 1) * 32 + fq * 8));
            }
            __builtin_amdgcn_sched_barrier(0);
#pragma unroll
            for (int nt = 0; nt < 8; ++nt) sacc[nt] = mfma16(kf[ks & 1][nt], qf[ks & 1], sacc[nt]);
            __builtin_amdgcn_sched_barrier(0);
        }
    }
    __syncthreads();
#pragma unroll
    for (int dir = 0; dir < 2; ++dir) {
        const float* A = sc + 256 + dir * 128; const float* IO = sc + 512 + dir * 128;
        const int i = wave * 16 + fr; const float Ai = A[i]; float rsum = 0.f;
        float p[8][4];
#pragma unroll
        for (int nt = 0; nt < 8; ++nt) {
            if (dir == 0 ? (nt > wave) : (nt < wave)) {
#pragma unroll
                for (int jj = 0; jj < 4; ++jj) p[nt][jj] = 0.f;
            } else {
                const f32x4 Aj = *(const f32x4*)(A + nt * 16 + fq * 4), Ij = *(const f32x4*)(IO + nt * 16 + fq * 4);
#pragma unroll
                for (int jj = 0; jj < 4; ++jj) {
                    const int j = nt * 16 + fq * 4 + jj;
                    const bool ok = dir == 0 ? (j <= i) : (mx == 0 ? (j > i) : (j >= i));
                    const float w = ok ? __expf(Ai - Aj[jj] + Ij[jj]) : 0.f;
                    p[nt][jj] = sacc[nt][jj] * w; rsum += p[nt][jj];
                }
            }
        }
        rsum += __shfl_xor(rsum, 16); rsum += __shfl_xor(rsum, 32);
        const float e = __expf(Ai); float inv = 1.f;
        if (mx == 1) { const float den = rsum + e * sc[768 + dir * 128 + i]; inv = 1.f / fmaxf(fabsf(den), 1.f); }
        if (fq == 0) sc[1024 + dir * 128 + i] = e * inv;
#pragma unroll
        for (int nt = 0; nt < 8; ++nt) {
            u32x2 w2; w2.x = pk2(p[nt][0] * inv, p[nt][1] * inv); w2.y = pk2(p[nt][2] * inv, p[nt][3] * inv);
            *(u32x2*)(lds + 32768 + dir * 32768 + swz(i, nt * 16 + fq * 4)) = w2;
        }
    }
    __syncthreads();
#pragma unroll
    for (int dir = 0; dir < 2; ++dir) {
        const bf16_t* Rb = ST + ((size_t)((dir * 16 + bh) * 32 + c) * 256 + wave * 32) * 128;
#pragma unroll
        for (int ks = 0; ks < 4; ++ks) { rfr[dir][ks][0] = *(const bf16x8*)(Rb + (fr) * 128 + ks * 32 + fq * 8); rfr[dir][ks][1] = *(const bf16x8*)(Rb + (16 + fr) * 128 + ks * 32 + fq * 8); }
    }
    {
        u32x4 qr[4]; float ff[4], fb[4];
#pragma unroll
        for (int k4 = 0; k4 < 4; ++k4) { const int j = (tid >> 4) + 32 * k4; qr[k4] = *(const u32x4*)(lds + swz(j, (tid & 15) * 8)); ff[k4] = sc[1024 + j]; fb[k4] = sc[1024 + 128 + j]; }
#pragma unroll
        for (int k4 = 0; k4 < 4; ++k4) {
            const int j = (tid >> 4) + 32 * k4;
            float q8[8], qa[8], qb[8]; unpack8(qr[k4], q8);
#pragma unroll
            for (int k = 0; k < 8; ++k) { qa[k] = q8[k] * ff[k4]; qb[k] = q8[k] * fb[k4]; }
            *(u32x4*)(lds + swz(j, (tid & 15) * 8)) = pack8(qa);
            *(u32x4*)(lds + 98304 + swz(j, (tid & 15) * 8)) = pack8(qb);
        }
    }
    __syncthreads();
    f32x4 hs[8][2];
#pragma unroll
    for (int mt = 0; mt < 8; ++mt) { hs[mt][0] = (f32x4){0.f, 0.f, 0.f, 0.f}; hs[mt][1] = (f32x4){0.f, 0.f, 0.f, 0.f}; }
    {
        bf16x8 fa[2][8];
#pragma unroll
        for (int mt = 0; mt < 8; ++mt) fa[0][mt] = *(const bf16x8*)(lds + swz(mt * 16 + fr, fq * 8));
#pragma unroll
        for (int st = 0; st < 16; ++st) {
            const int dir = st >> 3, intra = (st >> 2) & 1, ks = st & 3;
            if (st + 1 < 16) {
                const int nd = (st + 1) >> 3, ni = ((st + 1) >> 2) & 1, nk = (st + 1) & 3;
                const unsigned char* T = ni ? (lds + 32768 + nd * 32768) : (lds + nd * 98304);
#pragma unroll
                for (int mt = 0; mt < 8; ++mt) fa[(st + 1) & 1][mt] = *(const bf16x8*)(T + swz(mt * 16 + fr, nk * 32 + fq * 8));
            }
            __builtin_amdgcn_sched_barrier(0);
            const bf16x8 b0 = intra ? vfr[ks][0] : rfr[dir][ks][0], b1 = intra ? vfr[ks][1] : rfr[dir][ks][1];
#pragma unroll
            for (int mt = 0; mt < 8; ++mt) { hs[mt][0] = mfma16(b0, fa[st & 1][mt], hs[mt][0]); hs[mt][1] = mfma16(b1, fa[st & 1][mt], hs[mt][1]); }
            __builtin_amdgcn_sched_barrier(0);
        }
    }
    const int gcol = (mx == 0 ? 1024 : 5120) + h * 256 + wave * 32;
    u32x2 gwv[8][2];
#pragma unroll
    for (int mt = 0; mt < 8; ++mt)
#pragma unroll
        for (int nt = 0; nt < 2; ++nt) gwv[mt][nt] = *(const u32x2*)(proj + (size_t)(tok0 + mt * 16 + fr) * PJ + gcol + nt * 16 + fq * 4);
    float* red1 = sc + 1280; float* red2 = sc + 2304;
#pragma unroll
    for (int mt = 0; mt < 8; ++mt) {
        float s1 = 0.f, s2 = 0.f;
#pragma unroll
        for (int nt = 0; nt < 2; ++nt)
#pragma unroll
            for (int jj = 0; jj < 4; ++jj) { const float v = hs[mt][nt][jj]; s1 += v; s2 += v * v; }
        s1 += __shfl_xor(s1, 16); s1 += __shfl_xor(s1, 32); s2 += __shfl_xor(s2, 16); s2 += __shfl_xor(s2, 32);
        if (fq == 0) { red1[(mt * 16 + fr) * 8 + wave] = s1; red2[(mt * 16 + fr) * 8 + wave] = s2; }
    }
    __syncthreads();
    const float* ng = a.in[9] + l * 1024 + h * 256 + wave * 32;
#pragma unroll
    for (int mt = 0; mt < 8; ++mt) {
        const int i = mt * 16 + fr;
        const f32x4 ra = *(const f32x4*)(red1 + i * 8), rb = *(const f32x4*)(red1 + i * 8 + 4), qa = *(const f32x4*)(red2 + i * 8), qb = *(const f32x4*)(red2 + i * 8 + 4);
        const float S1 = ((ra[0] + ra[1]) + (ra[2] + ra[3])) + ((rb[0] + rb[1]) + (rb[2] + rb[3])), S2 = ((qa[0] + qa[1]) + (qa[2] + qa[3])) + ((qb[0] + qb[1]) + (qb[2] + qb[3]));
        const float mean = S1 * (1.f / 256.f), var = fmaxf(S2 * (1.f / 256.f) - mean * mean, 0.f), rstd = rsqrtf(var + EPSF);
#pragma unroll
        for (int nt = 0; nt < 2; ++nt) {
            const int e0 = nt * 16 + fq * 4;
            bf16_t* gp = proj + (size_t)(tok0 + i) * PJ + gcol + e0;
            const u32x2 gw = gwv[mt][nt];
            f32x4 y = (hs[mt][nt] - mean) * rstd;
            if (mx == 1) { const f32x4 g4 = *(const f32x4*)(ng + e0); y = y * g4; }
            u32x2 w; w.x = pk2(y[0] * bflo(gw.x), y[1] * bfhi(gw.x)); w.y = pk2(y[2] * bflo(gw.y), y[3] * bfhi(gw.y));
            *(u32x2*)gp = w;
        }
    }
    __syncthreads();
}

constexpr int NA_KP = 144, NA_VP = 136;
constexpr int NA_VOFF = 9 * 64 * NA_KP, NA_BOFF = NA_VOFF + 9 * 64 * NA_VP;
static_assert(NA_BOFF + 465 * 4 <= LDS_BYTES - 64, "NA LDS map");
struct NaStage { u32x4 kv[9], vv[9]; float bias; };
DI void na_load(const Args& a, int l, int u, int tid, NaStage& st) {
    const bf16_t* proj = (const bf16_t*)(a.ws + OFF_PROJ); const bf16_t* vt = (const bf16_t*)(a.ws + OFF_VT);
    const int rp = u & 31, head = (u >> 5) & 15, b = u >> 9, r0 = rp * 2, rs0 = min(max(r0 - 4, 0), 56);
    const int sub = tid & 7, rowi = tid >> 3, nkr = (rs0 + 8 <= 63) ? 9 : 8;
#pragma unroll
    for (int kr = 0; kr < 9; ++kr) if (kr < nkr) {
        st.kv[kr] = *(const u32x4*)(proj + (size_t)(b * SEQ + (rs0 + kr) * 64 + rowi) * PJ + 3072 + head * 64 + sub * 8);
        st.vv[kr] = *(const u32x4*)(vt + (size_t)(1024 + head * 64 + rowi) * MT + b * SEQ + (rs0 + kr) * 64 + sub * 8);
    }
    st.bias = tid < 465 ? a.in[5][(size_t)(l * 16 + head) * 465 + tid] : 0.f;
}
DI void na_store(int u, int tid, const NaStage& st, unsigned char* lds) {
    const int rp = u & 31, r0 = rp * 2, rs0 = min(max(r0 - 4, 0), 56);
    const int sub = tid & 7, rowi = tid >> 3, nkr = (rs0 + 8 <= 63) ? 9 : 8;
#pragma unroll
    for (int kr = 0; kr < 9; ++kr) if (kr < nkr) {
        *(u32x4*)(lds + (kr * 64 + rowi) * NA_KP + sub * 16) = st.kv[kr];
        *(u32x2*)(lds + NA_VOFF + (kr * 64 + rowi) * NA_VP + sub * 16) = (u32x2){st.vv[kr].x, st.vv[kr].y};
        *(u32x2*)(lds + NA_VOFF + (kr * 64 + rowi) * NA_VP + sub * 16 + 8) = (u32x2){st.vv[kr].z, st.vv[kr].w};
    }
    if (tid < 465) ((float*)(lds + NA_BOFF))[tid] = st.bias;
}
DI void na_phase(const Args& a, int l, unsigned char* lds, int tid, int xcc, int xrank, bool xo) {
    asm volatile("" : "+v"(tid));
    const int G = gridDim.x;
    bf16_t* proj = (bf16_t*)(a.ws + OFF_PROJ);
    const int wave = tid >> 6, lane = tid & 63, fr = lane & 15, fq = lane >> 4;
    NaStage st;
    const int ubase = xo ? (xcc * 8) * 32 + xrank : blockIdx.x, ustep = xo ? 32 : G, ucnt = xo ? 8 : (2048 - (int)blockIdx.x + G - 1) / G;
    if (ucnt > 0) na_load(a, l, ubase, tid, st);
#pragma unroll 1
    for (int ui = 0; ui < ucnt; ++ui) {
    const int u = ubase + ui * ustep;
    const int rp = u & 31, head = (u >> 5) & 15, b = u >> 9, r0 = rp * 2;
    const int rs0 = min(max(r0 - 4, 0), 56);
    const int r = r0 + (wave >> 2), cb = wave & 3, rs = min(max(r - 4, 0), 56), kro = rs - rs0;
    const int kc0 = cb == 0 ? 0 : (cb == 1 ? 8 : (cb == 2 ? 24 : 32));
    bf16_t* qp = proj + (size_t)(b * SEQ + r * 64 + cb * 16 + fr) * PJ + 2048 + head * 64;
    const bf16x8 qf0 = *(const bf16x8*)(qp + fq * 8), qf1 = *(const bf16x8*)(qp + 32 + fq * 8);
    na_store(u, tid, st, lds);
    if (ui + 1 < ucnt) na_load(a, l, u + ustep, tid, st);
    __syncthreads();
    f32x4 s[16];
    {
        bf16x8 kf[2][8];
#pragma unroll
        for (int t = 0; t < 4; ++t) {
            const unsigned char* kp = lds + ((kro + (t >> 1)) * 64 + kc0 + (t & 1) * 16 + fr) * NA_KP + fq * 16;
            kf[0][2 * t] = *(const bf16x8*)kp; kf[0][2 * t + 1] = *(const bf16x8*)(kp + 64);
        }
#pragma unroll
        for (int bt = 0; bt < 4; ++bt) {
            if (bt + 1 < 4) {
#pragma unroll
                for (int t = 0; t < 4; ++t) {
                    const int nt = (bt + 1) * 4 + t;
                    const unsigned char* kp = lds + ((kro + (nt >> 1)) * 64 + kc0 + (nt & 1) * 16 + fr) * NA_KP + fq * 16;
                    kf[(bt + 1) & 1][2 * t] = *(const bf16x8*)kp; kf[(bt + 1) & 1][2 * t + 1] = *(const bf16x8*)(kp + 64);
                }
            }
            __builtin_amdgcn_sched_barrier(0);
#pragma unroll
            for (int t = 0; t < 4; ++t) {
                f32x4 z = (f32x4){0.f, 0.f, 0.f, 0.f};
                z = mfma16(kf[bt & 1][2 * t], qf0, z); z = mfma16(kf[bt & 1][2 * t + 1], qf1, z);
                s[bt * 4 + t] = z;
            }
            __builtin_amdgcn_sched_barrier(0);
        }
    }
    const int cq = cb * 16 + fr, sc0 = min(max(cq - 8, 0), 48);
    const float* rpl = (const float*)(lds + NA_BOFF);
    float mxv = -1e30f;
#pragma unroll
    for (int nt = 0; nt < 16; ++nt)
#pragma unroll
        for (int jj = 0; jj < 4; ++jj) {
            const int kc = kc0 + (nt & 1) * 16 + fq * 4 + jj;
            const bool ok = (kc >= sc0) && (kc < sc0 + 16);
            const int rr = rs + (nt >> 1) - r + 7, cr = min(max(kc - cq + 15, 0), 30);
            const float v = ok ? s[nt][jj] + rpl[rr * 31 + cr] : -1e30f;
            s[nt][jj] = v; mxv = fmaxf(mxv, v);
        }
    mxv = fmaxf(mxv, __shfl_xor(mxv, 16)); mxv = fmaxf(mxv, __shfl_xor(mxv, 32));
    float sum = 0.f;
#pragma unroll
    for (int nt = 0; nt < 16; ++nt)
#pragma unroll
        for (int jj = 0; jj < 4; ++jj) { const float p = __expf(s[nt][jj] - mxv); s[nt][jj] = p; sum += p; }
    sum += __shfl_xor(sum, 16); sum += __shfl_xor(sum, 32);
    const float inv = 1.f / sum;
    f32x4 o[4];
#pragma unroll
    for (int et = 0; et < 4; ++et) o[et] = (f32x4){0.f, 0.f, 0.f, 0.f};
    {
        u32x4 vw[2][4];
#pragma unroll
        for (int et = 0; et < 4; ++et) {
            const unsigned char* vp = lds + NA_VOFF + ((kro + 0) * 64 + et * 16 + fr) * NA_VP + (kc0 + fq * 4) * 2;
            const u32x2 lo = *(const u32x2*)vp, hi = *(const u32x2*)(vp + 32);
            vw[0][et].x = lo.x; vw[0][et].y = lo.y; vw[0][et].z = hi.x; vw[0][et].w = hi.y;
        }
#pragma unroll
        for (int ks = 0; ks < 8; ++ks) {
            if (ks + 1 < 8) {
#pragma unroll
                for (int et = 0; et < 4; ++et) {
                    const unsigned char* vp = lds + NA_VOFF + ((kro + ks + 1) * 64 + et * 16 + fr) * NA_VP + (kc0 + fq * 4) * 2;
                    const u32x2 lo = *(const u32x2*)vp, hi = *(const u32x2*)(vp + 32);
                    vw[(ks + 1) & 1][et].x = lo.x; vw[(ks + 1) & 1][et].y = lo.y; vw[(ks + 1) & 1][et].z = hi.x; vw[(ks + 1) & 1][et].w = hi.y;
                }
            }
            u32x4 pw; pw.x = pk2(s[2 * ks][0], s[2 * ks][1]); pw.y = pk2(s[2 * ks][2], s[2 * ks][3]); pw.z = pk2(s[2 * ks + 1][0], s[2 * ks + 1][1]); pw.w = pk2(s[2 * ks + 1][2], s[2 * ks + 1][3]);
            const bf16x8 pf = __builtin_bit_cast(bf16x8, pw);
            __builtin_amdgcn_sched_barrier(0);
#pragma unroll
            for (int et = 0; et < 4; ++et) o[et] = mfma16(__builtin_bit_cast(bf16x8, vw[ks & 1][et]), pf, o[et]);
            __builtin_amdgcn_sched_barrier(0);
        }
    }
#pragma unroll
    for (int et = 0; et < 4; ++et) {
        u32x2 w; w.x = pk2(o[et][0] * inv, o[et][1] * inv); w.y = pk2(o[et][2] * inv, o[et][3] * inv);
        *(u32x2*)(qp + et * 16 + fq * 4) = w;
    }
    __syncthreads();
    }
}

DI int opaque_bx() { int bx = blockIdx.x; asm volatile("" : "+s"(bx)); return bx; }
template <bool BYCOL, int NU>
DI void fill_rstd(const pg8::StaticOrder& S, const float* ssp, float* rt, int* pt, int tid) {
    __syncthreads();
    constexpr int NIT = (NU * 256 + NTHR - 1) / NTHR;
    float v[NIT];
#pragma unroll
    for (int k = 0; k < NIT; ++k) {
        const int idx = tid + k * NTHR, i = __builtin_amdgcn_readfirstlane(idx >> 8), t = idx & 255;
        pg8::Unit uu; const bool ok = (i < NU) && S.next(i, uu); const int tile = BYCOL ? uu.pn : uu.pm;
        v[k] = ok ? row_rstd(ssp, tile * 256 + t) : 0.f;
        if (t == 0 && i < NU) pt[i] = ok ? tile : -1;
    }
    asm volatile("" : "+v"(tid));
#pragma unroll
    for (int k = 0; k < NIT; ++k) { const int idx = tid + k * NTHR; if (idx < NU * 256) rt[idx] = v[k]; }
    __syncthreads();
}
#define LAS __attribute__((address_space(3)))
#define XB_TMO      128
#define XB_XCNT(j)  (256  + 64 * (j))
#define XB_XSUB(j)  (1280 + 64 * (j))
#define XB_XGEN(j)  (2304 + 64 * (j))
#define XB_TOP      3328
#define XB_TOPGEN   3392
#define XCD_BAR_WORDS 3456
#define XB_SPIN_CAP (1u << 18)

__device__ __forceinline__ unsigned xb_ld(unsigned* p)              { return __hip_atomic_load(p, __ATOMIC_RELAXED, __HIP_MEMORY_SCOPE_AGENT); }
__device__ __forceinline__ unsigned xb_add(unsigned* p, unsigned v) { return __hip_atomic_fetch_add(p, v, __ATOMIC_RELAXED, __HIP_MEMORY_SCOPE_AGENT); }
__device__ __forceinline__ unsigned xb_xcc_id() { return (unsigned)__builtin_amdgcn_s_getreg((3 << 11) | 20) & 0xFu; }
#define XB_SPIN(cond, bar) do { unsigned _sp = 0; while (cond) { __builtin_amdgcn_s_sleep(1); \
    if ((++_sp & 255u) == 0u) { if (xb_ld(&(bar)[XB_TMO])) break; if (_sp > XB_SPIN_CAP) { atomicAdd(&(bar)[XB_TMO], 1u); break; } } } } while (0)

struct XcdBarrier {
    unsigned* bar; unsigned x;
    volatile LAS unsigned* st;
};

__device__ __forceinline__ XcdBarrier xcd_barrier_post(unsigned* bar, volatile LAS unsigned* st) {
    XcdBarrier b; b.bar = bar; b.x = xb_xcc_id(); b.st = st;
    if (threadIdx.x == 0) (void)xb_add(&bar[XB_XCNT(b.x)], 1u);
    return b;
}
__device__ __forceinline__ void xcd_barrier_complete(unsigned* bar, unsigned x, unsigned& nloc, unsigned& nx) {
    const unsigned G = gridDim.x * gridDim.y * gridDim.z;
    unsigned sum, cnt, mine, sp = 0u;
    for (;;) {
        sum = 0u; cnt = 0u; mine = 0u;
#pragma unroll
        for (unsigned j = 0; j < 16; ++j) { const unsigned c = xb_ld(&bar[XB_XCNT(j)]); sum += c; cnt += (c > 0u) ? 1u : 0u; mine = (j == x) ? c : mine; }
        if (sum == G) break;
        __builtin_amdgcn_s_sleep(1);
        if ((++sp & 255u) == 0u) { if (xb_ld(&bar[XB_TMO])) break; if (sp > XB_SPIN_CAP) { atomicAdd(&bar[XB_TMO], 1u); break; } }
    }
    nloc = mine > 0u ? mine : 1u; nx = cnt > 0u ? cnt : 1u;
}

__device__ __forceinline__ void xcd_barrier(const XcdBarrier& b) {
    asm volatile("s_waitcnt vmcnt(0)" ::: "memory");
    __syncthreads();
    if (threadIdx.x == 0) {
        unsigned* bar = b.bar;
        __builtin_amdgcn_s_waitcnt(0);
        unsigned nloc = b.st[0], nx = b.st[1];
        if (nloc == 0u) { xcd_barrier_complete(bar, b.x, nloc, nx); b.st[0] = nloc; b.st[1] = nx; }
        const unsigned old = xb_add(&bar[XB_XSUB(b.x)], 1u);
        const unsigned gen = old / nloc;
        if (old + 1u == (gen + 1u) * nloc) {
            __builtin_amdgcn_fence(__ATOMIC_RELEASE, "agent");
            asm volatile("s_waitcnt vmcnt(0)" ::: "memory");
            const unsigned og = xb_add(&bar[XB_TOP], 1u);
            const unsigned tg = og / nx;
            if (og + 1u == (tg + 1u) * nx) xb_add(&bar[XB_TOPGEN], 1u);
            else XB_SPIN(xb_ld(&bar[XB_TOPGEN]) == tg, bar);
            __builtin_amdgcn_fence(__ATOMIC_ACQUIRE, "agent");
            xb_add(&bar[XB_XGEN(b.x)], 1u);
            asm volatile("s_waitcnt vmcnt(0)" ::: "memory");
        } else {
            XB_SPIN(xb_ld(&bar[XB_XGEN(b.x)]) == gen, bar);
            __builtin_amdgcn_fence(__ATOMIC_ACQUIRE, "agent");
            asm volatile("s_waitcnt vmcnt(0)" ::: "memory");
        }
    }
    __syncthreads();
}

#define ARGS_HERE(name) int z_##name = 0; asm volatile("" : "+s"(z_##name)); const Args& name = *(const Args*)((const char*)__builtin_amdgcn_kernarg_segment_ptr() + z_##name)
__global__ void __launch_bounds__(NTHR, 2) mega_fwd(Args a_unused) {
    extern __shared__ __attribute__((aligned(16))) unsigned char lds[];
    cg::grid_group grid = cg::this_grid();
    const int tid = threadIdx.x, G = gridDim.x;
    PG8_LAS unsigned char* lds3 = (PG8_LAS unsigned char*)lds;
    volatile LAS unsigned* bst = (volatile LAS unsigned*)(lds3 + LDS_BYTES - 64);
    if (tid < 8) bst[tid] = 0u;
    __syncthreads();
    XcdBarrier bar;
    { ARGS_HERE(a); bar = xcd_barrier_post((unsigned*)(a.ws + OFF_BAR), bst);
      if (tid == 0) { const unsigned xc = xb_xcc_id(); bst[2] = xc; bst[3] = xb_add((unsigned*)(a.ws + OFF_BAR) + 3584 + 32 * xc, 1u); } }
#define GRID_SYNC() xcd_barrier(bar)
    { ARGS_HERE(a); prologue(a, lds, tid); }
    grid.sync();
    {
        ARGS_HERE(a);
        if (tid == 0) { unsigned okc = (G == 256) ? 1u : 0u; for (int j = 0; j < 16; ++j) { const unsigned c = xb_ld((unsigned*)(a.ws + OFF_BAR) + 3584 + 32 * j); if (c != (j < 8 ? 32u : 0u)) okc = 0u; } bst[4] = okc; }
        __syncthreads();
    }
#pragma unroll 1
    for (int l = 0; l < NL; ++l) {
        {
            ARGS_HERE(a);
            const unsigned char* wb = a.ws + OFF_WB + (size_t)l * LAYER_W; const bf16_t* xb = (const bf16_t*)(a.ws + OFF_XB); const float* ss = (const float*)(a.ws + OFF_SS) + (size_t)(2 * l) * MT * 16;
            float* rt = (float*)(lds + 131072); int* pt = (int*)(lds + 131072 + 12288);
            {
                pg8::Gemm g{xb, (const bf16_t*)(wb + LW_WIN), MT, PJ, DM, DM, DM}; pg8::StaticOrder S; S.init(MT, PJ, G, opaque_bx());
                fill_rstd<false, 9>(S, ss, rt, pt, tid);
                EpiInProj E{(bf16_t*)(a.ws + OFF_PROJ), rt, pt, 9, (const float*)(a.ws + OFF_COS), (const float*)(a.ws + OFF_SIN), a.in[3] + l * 3072};
                pg8::gemm_phase<EpiInProj, pg8::StaticOrder, true, true>(lds3, g, S, E);
            }
            {
                pg8::Gemm g{(const bf16_t*)(wb + LW_WV), xb, NVT, MT, DM, DM, DM}; pg8::StaticOrder S; S.init(NVT, MT, G, opaque_bx()); S.wgm = 8;
                fill_rstd<true, 3>(S, ss, rt, pt, tid);
                EpiVt E{(bf16_t*)(a.ws + OFF_VT), rt, pt};
                pg8::gemm_phase<EpiVt, pg8::StaticOrder, true, true>(lds3, g, S, E);
                int tw = tid; asm volatile("" : "+v"(tw));
                if ((tw >> 6) < 4) { for (int t16 = blockIdx.x * 4 + (tw >> 6); t16 < MT / 16; t16 += G * 4) mgate_tile(a, l, t16, tw & 63); }
            }
        }
        GRID_SYNC();
        {
            ARGS_HERE(a);
            na_phase(a, l, lds, tid, (int)bst[2], (int)bst[3], bst[4] != 0u);
#pragma unroll 1
            for (int u = blockIdx.x; u < 1024; u += G) s1_unit(a, l, u >> 9, (u >> 7) & 3, (u >> 5) & 3, u & 31, lds, tid);
        }
        GRID_SYNC();
        { ARGS_HERE(a); s2_scan(a, 1); s2_scan(a, 0); }
        GRID_SYNC();
        {
            ARGS_HERE(a);
#pragma unroll 1
            for (int u = blockIdx.x; u < 1024; u += G) s3_unit(a, l, u >> 9, (u >> 7) & 3, (u >> 5) & 3, u & 31, lds, tid);
        }
        GRID_SYNC();
        {
            ARGS_HERE(a);
            const unsigned char* wb = a.ws + OFF_WB + (size_t)l * LAYER_W; const bf16_t* proj = (const bf16_t*)(a.ws + OFF_PROJ);
            pg8::Gemm g{proj, (const bf16_t*)(wb + LW_WO), MT, 3 * DM, DM, PJ, DM}; OutProjOrder S; S.S0.init(MT, DM, G, opaque_bx());
            EpiOutProj E{proj, (bf16_t*)(a.ws + OFF_MB)};
            pg8::gemm_phase<EpiOutProj, OutProjOrder, true, true>(lds3, g, S, E);
        }
        GRID_SYNC();
#pragma unroll 1
        for (int ph = 0; ph < 3; ++ph) {
            ARGS_HERE(a);
            const unsigned char* wb = a.ws + OFF_WB + (size_t)l * LAYER_W;
            float* xw = a.out; bf16_t* xb = (bf16_t*)(a.ws + OFF_XB); float* ss = (float*)(a.ws + OFF_SS);
            if (ph != 1) {
                pg8::Gemm g{(const bf16_t*)(a.ws + (ph == 0 ? OFF_MB : OFF_HID)), (const bf16_t*)(wb + (ph == 0 ? LW_WOUT : LW_WDN)), MT, DM, ph == 0 ? DM : FF, ph == 0 ? DM : FF, ph == 0 ? DM : FF};
                pg8::StaticOrder S; S.init(MT, DM, G, opaque_bx());
#ifdef DUP_RESID
                { EpiResid E2{xw, (float*)(a.ws + OFF_X), (bf16_t*)(a.ws + OFF_ST), (float*)(a.ws + OFF_MG)};
                  pg8::gemm_phase<EpiResid, pg8::StaticOrder, true, true>(lds3, g, S, E2); }
#endif
                const float* xin = xw; if (l == 0 && ph == 0) xin = a.in[0];
                EpiResid E{xin, xw, xb, ss + (size_t)(2 * l + 1 + (ph >> 1)) * MT * 16};
                pg8::gemm_phase<EpiResid, pg8::StaticOrder, true, true>(lds3, g, S, E);
            } else
            {
                pg8::Gemm g{xb, (const bf16_t*)(wb + LW_WUP), MT, FF2, DM, DM, DM}; pg8::StaticOrder S; S.init(MT, FF2, G, opaque_bx());
                float* rt = (float*)(lds + 131072); int* pt = (int*)(lds + 131072 + 12288);
                fill_rstd<false, 6>(S, ss + (size_t)(2 * l + 1) * MT * 16, rt, pt, tid);
                EpiSwiGLU E{(bf16_t*)(a.ws + OFF_HID), rt, pt, 6};
                pg8::gemm_phase<EpiSwiGLU, pg8::StaticOrder, true, true>(lds3, g, S, E);
            }
            GRID_SYNC();
        }
    }
    {
        ARGS_HERE(a);
        const float* xw = a.out;
        const float* ssf = (const float*)(a.ws + OFF_SS) + (size_t)8 * MT * 16; const float* fg = a.in[17];
        int tf = tid; asm volatile("" : "+v"(tf));
        const int wave = tf >> 6, lane = tf & 63;
        f32x4 g4[4];
#pragma unroll
        for (int j = 0; j < 4; ++j) g4[j] = *(const f32x4*)(fg + 4 * lane + 256 * j);
        for (int m = blockIdx.x * 8 + wave; m < MT; m += 4 * G * 8) {
            float rs[4]; f32x4 v[4][4];
#pragma unroll
            for (int r = 0; r < 4; ++r) {
                const int mr = min(m + r * G * 8, MT - 1);
                rs[r] = row_rstd(ssf, mr);
#pragma unroll
                for (int j = 0; j < 4; ++j) v[r][j] = *(const f32x4*)(xw + (size_t)mr * DM + 4 * lane + 256 * j);
            }
#pragma unroll
            for (int r = 0; r < 4; ++r) {
                const int mr = m + r * G * 8;
                if (mr < MT) {
#pragma unroll
                    for (int j = 0; j < 4; ++j) *(f32x4*)(a.out + (size_t)mr * DM + 4 * lane + 256 * j) = v[r][j] * rs[r] * g4[j];
                }
            }
        }
    }
}

extern "C" void kernel_launch(void* const* d_in, const int* in_sizes, int n_in, void* d_out, int out_size, void* d_ws, size_t ws_size, hipStream_t stream) {
    static int grid = 0;
    if (grid == 0) {
        if (n_in != 18 || out_size != MT * DM || ws_size < WS_END) { fprintf(stderr, "kernel_launch: unexpected shapes / workspace (%d inputs, out %d, ws %zu < %zu)\n", n_in, out_size, ws_size, (size_t)WS_END); grid = -1; return; }
        int dev = 0, cus = 0, per_cu = 0;
        hipGetDevice(&dev);
        hipDeviceGetAttribute(&cus, hipDeviceAttributeMultiprocessorCount, dev);
        hipFuncSetAttribute((const void*)mega_fwd, hipFuncAttributeMaxDynamicSharedMemorySize, LDS_BYTES);
        hipOccupancyMaxActiveBlocksPerMultiprocessor(&per_cu, (const void*)mega_fwd, NTHR, LDS_BYTES);
        (void)hipGetLastError();
        if (per_cu < 1) per_cu = 1;
        grid = cus * 1;
    }
    if (grid < 0) return;
    Args a{};
    for (int i = 0; i < 18; ++i) a.in[i] = (const float*)d_in[i];
    a.out = (float*)d_out; a.ws = (unsigned char*)d_ws;
    (void)hipMemsetAsync((unsigned char*)d_ws + OFF_BAR, 0, BAR_BYTES, stream);
    void* args[] = {&a};
    hipError_t e = hipLaunchCooperativeKernel((const void*)mega_fwd, dim3(grid), dim3(NTHR), args, LDS_BYTES, stream);
    if (e != hipSuccess) fprintf(stderr, "cooperative launch failed: %s (grid %d)\n", hipGetErrorString(e), grid);
}
```
